# Optimizing an MI355X kernel written in HIP

```python
import jax, jax.numpy as jnp
from jax import lax
import numpy as np

D_MODEL = 1024
BATCH = 4
SEQ = 4096
DEPTH = 1

D_CONV = D_MODEL // 2
D_ATTN = D_MODEL - D_CONV
D_MIX = D_CONV + D_ATTN
HEAD_DIM = 64
N_HEADS = D_ATTN // HEAD_DIM
CONV_GROUPS = D_CONV // HEAD_DIM
CONV_WIDTH = 3
ROPE_DIM = HEAD_DIM // 4
ROPE_THETA = 500000.0
N_IDX_HEADS = 8
IDX_DIM = 64
TOPK_MAX = 256
Q_BLOCK = 128
EPS = 1e-6

kernel_name = "hybrid_conv_dsa_parallel_heads"

SPLIT_SIZES = [D_CONV, D_CONV, D_CONV, D_CONV,
               D_ATTN, D_ATTN, D_ATTN, D_ATTN,
               N_IDX_HEADS * IDX_DIM, IDX_DIM, N_IDX_HEADS]
D_IN = sum(SPLIT_SIZES)


def rmsnorm(x, gain):
    xf = x.astype(jnp.float32)
    inv = lax.rsqrt(jnp.mean(xf * xf, axis=-1, keepdims=True) + EPS)
    return (xf * inv).astype(x.dtype) * gain


def group_rmsnorm(y, gain, n_groups):
    shp = y.shape
    yg = y.reshape(shp[:-1] + (n_groups, shp[-1] // n_groups)).astype(jnp.float32)
    inv = lax.rsqrt(jnp.mean(yg * yg, axis=-1, keepdims=True) + EPS)
    return (yg * inv).reshape(shp).astype(y.dtype) * gain


def rope_partial(x, positions):
    half = ROPE_DIM // 2
    inv_freq = ROPE_THETA ** (-jnp.arange(half, dtype=jnp.float32) / half)
    ang = positions.astype(jnp.float32)[..., None] * inv_freq
    cos = jnp.cos(ang)[:, :, None, :]
    sin = jnp.sin(ang)[:, :, None, :]
    xr = x[..., :ROPE_DIM].astype(jnp.float32)
    x1, x2 = xr[..., :half], xr[..., half:]
    rot = jnp.concatenate([x1 * cos - x2 * sin, x1 * sin + x2 * cos], axis=-1).astype(x.dtype)
    return jnp.concatenate([rot, x[..., ROPE_DIM:]], axis=-1)


def short_conv_mixer(b_gate, c_gate, u, conv_w, conv_b):
    s = c_gate * u
    L = s.shape[1]
    sp = jnp.pad(s, ((0, 0), (CONV_WIDTH - 1, 0), (0, 0)))
    conv = conv_b + sum(conv_w[j] * sp[:, j:j + L, :] for j in range(CONV_WIDTH))
    return b_gate * conv


def dsa_sparse_attention(q, k, v, q_idx, k_idx, w_idx):
    Bsz, L = q.shape[0], q.shape[1]
    topk = min(TOPK_MAX, L // 4)
    n_blocks = L // Q_BLOCK
    idx_scale = IDX_DIM ** -0.5
    att_scale = HEAD_DIM ** -0.5
    key_pos = jnp.arange(L)
    gather = jax.vmap(lambda kb, ib: kb[ib])

    def block(i):
        t0 = i * Q_BLOCK
        q_b = lax.dynamic_slice_in_dim(q, t0, Q_BLOCK, axis=1)
        qi_b = lax.dynamic_slice_in_dim(q_idx, t0, Q_BLOCK, axis=1)
        wi_b = lax.dynamic_slice_in_dim(w_idx, t0, Q_BLOCK, axis=1)
        tq = t0 + jnp.arange(Q_BLOCK)
        dots = jnp.einsum('bqhd,bsd->bqhs', qi_b, k_idx) * idx_scale
        score = jnp.einsum('bqh,bqhs->bqs', wi_b.astype(jnp.float32),
                           jax.nn.relu(dots).astype(jnp.float32))
        causal = key_pos[None, :] <= tq[:, None]
        score = jnp.where(causal[None], score, -jnp.inf)
        _, sel = lax.top_k(score, topk)
        valid = sel <= tq[None, :, None]
        k_sel = gather(k, sel)
        v_sel = gather(v, sel)
        logits = jnp.einsum('bqhd,bqkhd->bqhk', q_b, k_sel).astype(jnp.float32) * att_scale
        logits = jnp.where(valid[:, :, None, :], logits, -jnp.inf)
        p = jax.nn.softmax(logits, axis=-1).astype(v.dtype)
        return jnp.einsum('bqhk,bqkhd->bqhd', p, v_sel)

    outs = lax.map(block, jnp.arange(n_blocks))
    return jnp.transpose(outs, (1, 0, 2, 3, 4)).reshape(Bsz, L, N_HEADS * HEAD_DIM)


def hybrid_layer(x, c, positions, w_ada, b_ada, norm_in, w_in, conv_w, conv_b,
                 gn_conv, gn_attn, w_out):
    Bsz, L, _ = x.shape
    mod = jax.nn.silu(c) @ w_ada + b_ada
    shift, scale, gate = jnp.split(mod, 3, axis=-1)
    h = rmsnorm(x, norm_in) * (1.0 + scale[:, None, :]) + shift[:, None, :]

    proj = h @ w_in
    cuts = [int(v) for v in np.cumsum(SPLIT_SIZES)[:-1]]
    (cb, cc, cu, cz, aq, ak, av, az, iq, ik, iw) = jnp.split(proj, cuts, axis=-1)

    y_conv = short_conv_mixer(cb, cc, cu, conv_w, conv_b)
    y_conv = group_rmsnorm(y_conv, gn_conv, CONV_GROUPS) * jax.nn.silu(cz)

    q = rope_partial(aq.reshape(Bsz, L, N_HEADS, HEAD_DIM), positions)
    k = rope_partial(ak.reshape(Bsz, L, N_HEADS, HEAD_DIM), positions)
    v = av.reshape(Bsz, L, N_HEADS, HEAD_DIM)
    q_idx = rope_partial(iq.reshape(Bsz, L, N_IDX_HEADS, IDX_DIM), positions)
    k_idx = rope_partial(ik[:, :, None, :], positions)[:, :, 0, :]
    w_idx = iw * (N_IDX_HEADS ** -0.5)
    y_attn = dsa_sparse_attention(q, k, v, q_idx, k_idx, w_idx)
    y_attn = group_rmsnorm(y_attn, gn_attn, N_HEADS) * jax.nn.silu(az)

    y = jnp.concatenate([y_conv, y_attn], axis=-1) @ w_out
    return x + gate[:, None, :] * y


def setup_inputs(seed: int = 0) -> dict:
    key = jax.random.key(seed)
    ks = jax.random.split(key, 14)
    f32 = jnp.float32
    x = jax.random.normal(ks[0], (BATCH, SEQ, D_MODEL), f32)
    c = jax.random.normal(ks[1], (BATCH, D_MODEL), f32)
    offsets = jax.random.randint(ks[2], (BATCH, 1), 0, 1024, dtype=jnp.int32)
    positions = (jnp.arange(SEQ, dtype=jnp.int32)[None, :] + offsets).astype(jnp.int32)
    w_ada = jax.random.normal(ks[3], (D_MODEL, 3 * D_MODEL), f32) * (0.5 * D_MODEL ** -0.5)
    b_ada = jax.random.normal(ks[4], (3 * D_MODEL,), f32) * 0.1
    norm_in = 1.0 + 0.05 * jax.random.normal(ks[5], (D_MODEL,), f32)
    w_in = jax.random.normal(ks[6], (D_MODEL, D_IN), f32) * (D_MODEL ** -0.5)
    conv_w = jax.random.normal(ks[7], (CONV_WIDTH, D_CONV), f32) * (CONV_WIDTH ** -0.5)
    conv_b = jax.random.normal(ks[8], (D_CONV,), f32) * 0.02
    gn_conv = 1.0 + 0.05 * jax.random.normal(ks[9], (D_CONV,), f32)
    gn_attn = 1.0 + 0.05 * jax.random.normal(ks[10], (D_ATTN,), f32)
    w_out = jax.random.normal(ks[11], (D_MIX, D_MODEL), f32) * (D_MIX ** -0.5)
    norm_f = 1.0 + 0.05 * jax.random.normal(ks[12], (D_MODEL,), f32)
    return {"x": x, "c": c, "positions": positions, "w_ada": w_ada, "b_ada": b_ada,
            "norm_in": norm_in, "w_in": w_in, "conv_w": conv_w, "conv_b": conv_b,
            "gn_conv": gn_conv, "gn_attn": gn_attn, "w_out": w_out, "norm_f": norm_f}


def reference(x, c, positions, w_ada, b_ada, norm_in, w_in, conv_w, conv_b,
              gn_conv, gn_attn, w_out, norm_f):
    h = x
    for _ in range(DEPTH):
        h = hybrid_layer(h, c, positions, w_ada, b_ada, norm_in, w_in, conv_w, conv_b,
                         gn_conv, gn_attn, w_out)
    return rmsnorm(h, norm_f)
```

```cpp
#include <hip/hip_runtime.h>
#include <cstdio>
#include <cstdint>
#include <cmath>
namespace pg8 {
#define PG8_LAS __attribute__((address_space(3)))
typedef unsigned short bf16_t;
typedef short bf16x8 __attribute__((ext_vector_type(8)));
typedef float f32x4 __attribute__((ext_vector_type(4)));
typedef unsigned u32x4 __attribute__((ext_vector_type(4)));
constexpr int BM = 256, BK = 64, HALF = 128, HTB = HALF * BK * 2  , STAGE_BYTES = 8 * HTB, NXCD = 8, WGM = 8;

__host__ __device__ __forceinline__ int lds_byte(int r, int c) { const int st = (r >> 4) * 2 + (c >> 5), rr = r & 15, cc = c & 31, ob = rr * 64 + cc * 2; return st * 1024 + (ob ^ (((ob >> 9) & 1) << 5)); }
__host__ __device__ __forceinline__ void stage_rc(int b, int& R, int& C) { const int st = b / 1024, sb = b % 1024, swz = sb ^ (((sb >> 9) & 1) << 5); R = (st >> 1) * 16 + swz / 64; C = (st & 1) * 32 + (swz % 64) / 2; }
__host__ __device__ __forceinline__ int perm32(int rho) { const int n = rho >> 4, i = rho & 15; return 8 * (i >> 2) + 4 * n + (i & 3); }

struct Unit { int pm, pn; };
struct Gemm { const bf16_t* A; const bf16_t* Bt; int M, N, K; };

struct StaticOrder {
    int nM, nN, nwg, G, c;
    __host__ __device__ void init(int M, int N, int G_, int c_) { nM = M / BM; nN = N / BM; nwg = nM * nN; G = G_; c = c_; }
    __host__ __device__ bool next(int i, Unit& u) const {
        const long L = (long)i * G + c; if (L >= nwg) return false;
        int wgid = (int)L; { const int q = nwg / NXCD, r = nwg % NXCD, xcd = wgid % NXCD, off = wgid / NXCD; wgid = (xcd < r ? xcd * (q + 1) : r * (q + 1) + (xcd - r) * q) + off; }
        const int nig = WGM * nN, gid = wgid / nig, fm = gid * WGM, gsz = (nM - fm) < WGM ? (nM - fm) : WGM;
        u.pm = fm + ((wgid % nig) % gsz); u.pn = (wgid % nig) / gsz; return true;
    }
    __device__ __forceinline__ void a_ready(const Unit&) const {}
    __device__ __forceinline__ void done(const Unit&) const {}
};

__device__ __forceinline__ unsigned cvt_pk_bf16(float lo, float hi) { unsigned r; asm volatile("v_cvt_pk_bf16_f32 %0, %1, %2" : "=v"(r) : "v"(lo), "v"(hi)); return r; }
typedef float f32x2 __attribute__((ext_vector_type(2)));
typedef _Float16 f16x8 __attribute__((ext_vector_type(8)));
typedef _Float16 f16x2 __attribute__((ext_vector_type(2)));
__device__ __forceinline__ unsigned cvt_pk_f16(float lo, float hi) { f16x2 v = {(_Float16)lo, (_Float16)hi}; return __builtin_bit_cast(unsigned, v); }
template <bool F16> __device__ __forceinline__ f32x4 mma16(bf16x8 a, bf16x8 b, f32x4 c) {
    if constexpr (F16) return __builtin_amdgcn_mfma_f32_16x16x32_f16(__builtin_bit_cast(f16x8, a), __builtin_bit_cast(f16x8, b), c, 0, 0, 0);
    else return __builtin_amdgcn_mfma_f32_16x16x32_bf16(a, b, c, 0, 0, 0);
}

struct EpiProj {
    static constexpr bool PERM = true, AFTER_DRAIN = false;
    bf16_t* O; int ldc; float* IW; float qscale, iwscale;
    __device__ __forceinline__ void operator()(const f32x4 (&acc)[2][2][4][2], const Unit& u, int wr, int wc, int fr, int fq) const {
        const int row0 = u.pm * BM + wr * 64 + fr; const int col0 = u.pn * BM + wc * 32 + 8 * fq;
        const float sc = (u.pn == 8 || u.pn == 9) ? qscale : 1.f; const bool h16 = u.pn >= 16;
#pragma unroll
        for (int ai = 0; ai < 2; ++ai)
#pragma unroll
            for (int m = 0; m < 4; ++m) { const int row = row0 + ai * HALF + m * 16; bf16_t* rowp = O + (size_t)row * ldc + col0;
#pragma unroll
                for (int bj = 0; bj < 2; ++bj) { const f32x4 v0 = acc[ai][bj][m][0] * sc, v1 = acc[ai][bj][m][1] * sc; u32x4 w;
                    if (h16) { w.x = cvt_pk_f16(v0[0], v0[1]); w.y = cvt_pk_f16(v0[2], v0[3]); w.z = cvt_pk_f16(v1[0], v1[1]); w.w = cvt_pk_f16(v1[2], v1[3]); }
                    else { w.x = cvt_pk_bf16(v0[0], v0[1]); w.y = cvt_pk_bf16(v0[2], v0[3]); w.z = cvt_pk_bf16(v1[0], v1[1]); w.w = cvt_pk_bf16(v1[2], v1[3]); }
                    *(u32x4*)(rowp + bj * HALF) = w;
                    if (bj == 0 && u.pn == 18 && wc == 2 && fq == 0) { float* ip = IW + (size_t)row * 8; *(f32x4*)ip = v0 * iwscale; *(f32x4*)(ip + 4) = v1 * iwscale; } } }
    }
};
struct EpiOut {
    static constexpr bool PERM = false, AFTER_DRAIN = false;
    const float* x; float* out; int ldc; const float* gate; int gstride; int rows_per_batch;
    __device__ __forceinline__ void operator()(const f32x4 (&acc)[2][2][4][2], const Unit& u, int wr, int wc, int fr, int fq) const {
        const int row0 = u.pm * BM + wr * 64 + fr; const int col0 = u.pn * BM + wc * 32 + 4 * fq;
        const float* g = gate + (size_t)((u.pm * BM) / rows_per_batch) * gstride;
        f32x4 gv[2][2];
#pragma unroll
        for (int bj = 0; bj < 2; ++bj)
#pragma unroll
            for (int n = 0; n < 2; ++n) gv[bj][n] = *(const f32x4*)(g + col0 + bj * HALF + n * 16);
#pragma unroll
        for (int ai = 0; ai < 2; ++ai)
#pragma unroll
            for (int m = 0; m < 4; ++m) { const size_t off = (size_t)(row0 + ai * HALF + m * 16) * ldc + col0;
#pragma unroll
                for (int bj = 0; bj < 2; ++bj)
#pragma unroll
                    for (int n = 0; n < 2; ++n) { const f32x4 xv = *(const f32x4*)(x + off + bj * HALF + n * 16);
                        *(f32x4*)(out + off + bj * HALF + n * 16) = xv + gv[bj][n] * acc[ai][bj][m][n]; } }
    }
};

template <class Epi, class Sched, bool ALIGN_EPI = false, bool SP2 = false, bool F16 = false>
__device__ __forceinline__ void gemm_phase(PG8_LAS unsigned char* lds, const Gemm g, const Sched& S, const Epi& E) {
    const int tid = threadIdx.x, wid = __builtin_amdgcn_readfirstlane(tid >> 6), lane = tid & 63, wr = wid >> 2, wc = wid & 3, fr = lane & 15, fq = lane >> 4;
    const int K = g.K, nt = K / BK;
    unsigned voffA[2], voffB[2];
#pragma unroll
    for (int i = 0; i < 2; ++i) { int R, C; stage_rc(tid * 16 + i * 8192, R, C); const int Rb = Epi::PERM ? ((R & ~31) + perm32(R & 31)) : R;
        voffA[i] = (unsigned)(R * K + C) * 2u; voffB[i] = (unsigned)(Rb * K + C) * 2u; }
    const size_t kstep = (size_t)(BK * 2);
    const size_t hstep = (size_t)HALF * K * 2;
    const size_t tstep = 2 * hstep;
    const unsigned ldsw = (unsigned)wid * 1024u;
    const int aoff = lds_byte(wr * 64 + fr, fq * 8), boff = lds_byte(wc * 32 + fr, fq * 8);
#define PG8_SA(b, h) (((b) * 2 + (h)) * HTB)
#define PG8_SB(b, h) ((4 + (b) * 2 + (h)) * HTB)
#define PG8_STAGE(bufoff, gbase, voff) do { _Pragma("unroll") for (int _i = 0; _i < 2; ++_i) \
        __builtin_amdgcn_global_load_lds((const unsigned*)((const char*)(gbase) + (voff)[_i]), (PG8_LAS unsigned*)(lds + (bufoff) + ldsw + _i * 8192), 16, 0, 0); } while (0)
#define PG8_LDA(dst, b, h) do { _Pragma("unroll") for (int m = 0; m < 4; ++m) _Pragma("unroll") for (int k = 0; k < 2; ++k) dst[m][k] = *(const PG8_LAS bf16x8*)(lds + PG8_SA(b, h) + aoff + m * 2048 + k * 1024); } while (0)
#define PG8_LDB(dst, b, h) do { _Pragma("unroll") for (int n = 0; n < 2; ++n) _Pragma("unroll") for (int k = 0; k < 2; ++k) dst[n][k] = *(const PG8_LAS bf16x8*)(lds + PG8_SB(b, h) + boff + n * 2048 + k * 1024); } while (0)
#define PG8_MMA(ai, bj, At, Bt) do { __builtin_amdgcn_s_setprio(1); _Pragma("unroll") for (int m = 0; m < 4; ++m) _Pragma("unroll") for (int n = 0; n < 2; ++n) _Pragma("unroll") for (int k = 0; k < 2; ++k) \
        acc[ai][bj][m][n] = mma16<F16>(Bt[n][k], At[m][k], acc[ai][bj][m][n]); __builtin_amdgcn_s_setprio(0); } while (0)
#define PG8_WAIT_V(n) asm volatile("s_waitcnt vmcnt(" #n ")" ::: "memory")
#define PG8_WAIT_L(n) asm volatile("s_waitcnt lgkmcnt(" #n ")" ::: "memory")
#define PG8_BAR __builtin_amdgcn_s_barrier()
#define PG8_SCHED __builtin_amdgcn_sched_barrier(0)
    Unit cur, nxt; int ui = 0;
    if (!S.next(0, cur)) return;
    f32x4 acc[2][2][4][2];
#pragma unroll
    for (int a = 0; a < 2; ++a)
#pragma unroll
        for (int b = 0; b < 2; ++b)
#pragma unroll
            for (int m = 0; m < 4; ++m)
#pragma unroll
                for (int n = 0; n < 2; ++n) acc[a][b][m][n] = (f32x4){0.f, 0.f, 0.f, 0.f};
    bf16x8 At[4][2], B0[2][2], B1[2][2];
    const char* cA = (const char*)g.A + (size_t)cur.pm * tstep; const char* cB = (const char*)g.Bt + (size_t)cur.pn * tstep;
    S.a_ready(cur);
    if constexpr (SP2) {
        PG8_STAGE(PG8_SB(0, 0), cB, voffB); PG8_STAGE(PG8_SB(0, 1), cB + hstep, voffB); PG8_STAGE(PG8_SA(0, 0), cA, voffA); PG8_STAGE(PG8_SA(0, 1), cA + hstep, voffA);
        if (wr == 1) PG8_BAR;
        PG8_WAIT_V(2); PG8_BAR;
        PG8_STAGE(PG8_SB(1, 0), cB + kstep, voffB); PG8_STAGE(PG8_SA(1, 0), cA + kstep, voffA); PG8_STAGE(PG8_SB(1, 1), cB + hstep + kstep, voffB);
        PG8_WAIT_V(6); PG8_BAR;
    } else {
        PG8_STAGE(PG8_SB(0, 0), cB, voffB); PG8_STAGE(PG8_SA(0, 0), cA, voffA); PG8_STAGE(PG8_SB(0, 1), cB + hstep, voffB); PG8_STAGE(PG8_SA(0, 1), cA + hstep, voffA);
        if (wr == 1) PG8_BAR;
        PG8_WAIT_V(4); PG8_BAR;
        PG8_STAGE(PG8_SB(1, 0), cB + kstep, voffB); PG8_STAGE(PG8_SA(1, 0), cA + kstep, voffA); PG8_STAGE(PG8_SB(1, 1), cB + hstep + kstep, voffB);
        PG8_WAIT_V(6); PG8_BAR;
    }
    for (;;) {
        const bool has_next = S.next(ui + 1, nxt);
        const char* nA = has_next ? (const char*)g.A + (size_t)nxt.pm * tstep : cA; const char* nB = has_next ? (const char*)g.Bt + (size_t)nxt.pn * tstep : cB;
        for (int t = 0; t < nt; t += 2) {
            const bool last = (t == nt - 2);
            const char* a1 = cA + (size_t)(t + 1) * kstep;
            const char* a2 = last ? nA : cA + (size_t)(t + 2) * kstep; const char* b2 = last ? nB : cB + (size_t)(t + 2) * kstep;
            const char* a3 = a2 + kstep; const char* b3 = b2 + kstep;
            if (last && has_next) S.a_ready(nxt);
            if constexpr (SP2) {
            PG8_LDB(B0, 0, 0); PG8_LDB(B1, 0, 1); PG8_SCHED; PG8_LDA(At, 0, 0); PG8_STAGE(PG8_SA(1, 1), a1 + hstep, voffA);
            PG8_WAIT_V(8); PG8_WAIT_L(0); PG8_BAR; PG8_MMA(0, 0, At, B0); PG8_MMA(0, 1, At, B1); PG8_BAR; PG8_SCHED;
            PG8_LDA(At, 0, 1); PG8_STAGE(PG8_SB(0, 0), b2, voffB); PG8_STAGE(PG8_SB(0, 1), b2 + hstep, voffB); PG8_STAGE(PG8_SA(0, 0), a2, voffA);
            PG8_WAIT_V(8); PG8_WAIT_L(0); PG8_BAR; PG8_MMA(1, 0, At, B0); PG8_MMA(1, 1, At, B1); PG8_BAR; PG8_SCHED;
            PG8_LDB(B0, 1, 0); PG8_LDB(B1, 1, 1); PG8_SCHED; PG8_LDA(At, 1, 0); PG8_STAGE(PG8_SA(0, 1), a2 + hstep, voffA);
            PG8_WAIT_V(8); PG8_WAIT_L(0); PG8_BAR; PG8_MMA(0, 0, At, B0); PG8_MMA(0, 1, At, B1); PG8_BAR; PG8_SCHED;
            PG8_LDA(At, 1, 1); PG8_STAGE(PG8_SB(1, 0), b3, voffB); PG8_STAGE(PG8_SB(1, 1), b3 + hstep, voffB); PG8_STAGE(PG8_SA(1, 0), a3, voffA);
            PG8_WAIT_V(8); PG8_WAIT_L(0); PG8_BAR; PG8_MMA(1, 0, At, B0); PG8_MMA(1, 1, At, B1); PG8_BAR; PG8_SCHED;
            } else {
            PG8_LDB(B0, 0, 0); PG8_SCHED; PG8_LDA(At, 0, 0); PG8_STAGE(PG8_SA(1, 1), a1 + hstep, voffA);
            PG8_WAIT_L(8); PG8_BAR; PG8_WAIT_L(0); PG8_MMA(0, 0, At, B0); PG8_BAR; PG8_SCHED;
            PG8_LDB(B1, 0, 1); PG8_STAGE(PG8_SB(0, 0), b2, voffB);
            PG8_BAR; PG8_WAIT_L(0); PG8_MMA(0, 1, At, B1); PG8_BAR;
            PG8_LDA(At, 0, 1); PG8_STAGE(PG8_SA(0, 0), a2, voffA);
            PG8_BAR; PG8_WAIT_L(0); PG8_MMA(1, 0, At, B0); PG8_BAR; PG8_SCHED;
            PG8_STAGE(PG8_SB(0, 1), b2 + hstep, voffB);
            PG8_WAIT_V(6); PG8_BAR; PG8_MMA(1, 1, At, B1); PG8_BAR;
            PG8_LDB(B0, 1, 0); PG8_SCHED; PG8_LDA(At, 1, 0); PG8_STAGE(PG8_SA(0, 1), a2 + hstep, voffA);
            PG8_WAIT_L(8); PG8_BAR; PG8_WAIT_L(0); PG8_MMA(0, 0, At, B0); PG8_BAR; PG8_SCHED;
            PG8_LDB(B1, 1, 1); PG8_STAGE(PG8_SB(1, 0), b3, voffB);
            PG8_BAR; PG8_WAIT_L(0); PG8_MMA(0, 1, At, B1); PG8_BAR;
            PG8_LDA(At, 1, 1); PG8_STAGE(PG8_SA(1, 0), a3, voffA);
            PG8_BAR; PG8_WAIT_L(0); PG8_MMA(1, 0, At, B0); PG8_BAR; PG8_SCHED;
            PG8_STAGE(PG8_SB(1, 1), b3 + hstep, voffB);
            PG8_WAIT_V(6); PG8_BAR; PG8_MMA(1, 1, At, B1); PG8_BAR;
            }
        }
        if constexpr (ALIGN_EPI) { if (wr == 0) PG8_BAR; }
        if constexpr (!Epi::AFTER_DRAIN) { E(acc, cur, wr, wc, fr, fq); S.done(cur); }
        if (!has_next) break;
#pragma unroll
        for (int a = 0; a < 2; ++a)
#pragma unroll
            for (int b = 0; b < 2; ++b)
#pragma unroll
                for (int m = 0; m < 4; ++m)
#pragma unroll
                    for (int n = 0; n < 2; ++n) acc[a][b][m][n] = (f32x4){0.f, 0.f, 0.f, 0.f};
        cur = nxt; cA = nA; cB = nB; ++ui;
        if constexpr (ALIGN_EPI) { if (wr == 1) PG8_BAR; }
    }
    PG8_WAIT_V(0);
    if constexpr (!ALIGN_EPI) { if (wr == 0) PG8_BAR; }
    PG8_BAR;
    if constexpr (Epi::AFTER_DRAIN) { E.fused(acc, cur, wr, wc, fr, fq, lds, wid, lane); S.done(cur); }
#undef PG8_SA
#undef PG8_SB
#undef PG8_STAGE
#undef PG8_LDA
#undef PG8_LDB
#undef PG8_MMA
#undef PG8_WAIT_V
#undef PG8_WAIT_L
#undef PG8_BAR
#undef PG8_SCHED
}
}

#define GAS __attribute__((address_space(1)))
#define LAS __attribute__((address_space(3)))
typedef unsigned short bf16;
typedef unsigned v4u __attribute__((ext_vector_type(4)));
typedef float f32x4 __attribute__((ext_vector_type(4)));
typedef short bf16x8 __attribute__((ext_vector_type(8)));
typedef GAS unsigned gu32;
typedef GAS unsigned long long gu64;
#define RLX_AGENT __ATOMIC_RELAXED, __HIP_MEMORY_SCOPE_AGENT
#define LDS_WAIT() asm volatile("s_waitcnt lgkmcnt(0)" ::: "memory")
#define VM_WAIT() asm volatile("s_waitcnt vmcnt(0)" ::: "memory")
__device__ __forceinline__ unsigned long long rt() { return __builtin_amdgcn_s_memrealtime(); }
__device__ __forceinline__ unsigned f2bf(float f) { unsigned u = __builtin_bit_cast(unsigned, f); return (u + 0x7fffu + ((u >> 16) & 1u)) >> 16; }
__device__ __forceinline__ unsigned pk2(float lo, float hi) { return f2bf(lo) | (f2bf(hi) << 16); }

#define XB_TMO      128
#define XB_XCNT(j)  (256  + 64 * (j))
#define XB_XSUB(j)  (1280 + 64 * (j))
#define XB_XGEN(j)  (2304 + 64 * (j))
#define XB_TOP      3328
#define XB_TOPGEN   3392
#define XCD_BAR_WORDS 3456
#define XB_SPIN_CAP (1u << 18)

__device__ __forceinline__ unsigned xb_ld(unsigned* p)              { return __hip_atomic_load(p, __ATOMIC_RELAXED, __HIP_MEMORY_SCOPE_AGENT); }
__device__ __forceinline__ unsigned xb_add(unsigned* p, unsigned v) { return __hip_atomic_fetch_add(p, v, __ATOMIC_RELAXED, __HIP_MEMORY_SCOPE_AGENT); }
__device__ __forceinline__ unsigned xb_xcc_id() { return (unsigned)__builtin_amdgcn_s_getreg((3 << 11) | 20) & 0xFu; }
#define XB_SPIN(cond, bar) do { unsigned _sp = 0; while (cond) { __builtin_amdgcn_s_sleep(1); \
    if ((++_sp & 255u) == 0u) { if (xb_ld(&(bar)[XB_TMO])) break; if (_sp > XB_SPIN_CAP) { atomicAdd(&(bar)[XB_TMO], 1u); break; } } } } while (0)

struct XcdBarrier {
    unsigned* bar; unsigned x;
    volatile LAS unsigned* st;
};

__device__ __forceinline__ XcdBarrier xcd_barrier_post(unsigned* bar, volatile LAS unsigned* st) {
    XcdBarrier b; b.bar = bar; b.x = xb_xcc_id(); b.st = st;
    if (threadIdx.x == 0) (void)xb_add(&bar[XB_XCNT(b.x)], 1u);
    return b;
}
__device__ __forceinline__ void xcd_barrier_complete(unsigned* bar, unsigned x, unsigned& nloc, unsigned& nx) {
    const unsigned G = gridDim.x * gridDim.y * gridDim.z;
    unsigned sum, cnt, mine, sp = 0u;
    for (;;) {
        sum = 0u; cnt = 0u; mine = 0u;
#pragma unroll
        for (unsigned j = 0; j < 16; ++j) { const unsigned c = xb_ld(&bar[XB_XCNT(j)]); sum += c; cnt += (c > 0u) ? 1u : 0u; mine = (j == x) ? c : mine; }
        if (sum == G) break;
        __builtin_amdgcn_s_sleep(1);
        if ((++sp & 255u) == 0u) { if (xb_ld(&bar[XB_TMO])) break; if (sp > XB_SPIN_CAP) { atomicAdd(&bar[XB_TMO], 1u); break; } }
    }
    nloc = mine > 0u ? mine : 1u; nx = cnt > 0u ? cnt : 1u;
}

__device__ __forceinline__ void xcd_barrier(const XcdBarrier& b) {
    asm volatile("s_waitcnt vmcnt(0)" ::: "memory");
    __syncthreads();
    if (threadIdx.x == 0) {
        unsigned* bar = b.bar;
        __builtin_amdgcn_s_waitcnt(0);
        unsigned nloc = b.st[0], nx = b.st[1];
        if (nloc == 0u) { xcd_barrier_complete(bar, b.x, nloc, nx); b.st[0] = nloc; b.st[1] = nx; }
        const unsigned old = xb_add(&bar[XB_XSUB(b.x)], 1u);
        const unsigned gen = old / nloc;
        if (old + 1u == (gen + 1u) * nloc) {
            __builtin_amdgcn_fence(__ATOMIC_RELEASE, "agent");
            asm volatile("s_waitcnt vmcnt(0)" ::: "memory");
            const unsigned og = xb_add(&bar[XB_TOP], 1u);
            const unsigned tg = og / nx;
            if (og + 1u == (tg + 1u) * nx) xb_add(&bar[XB_TOPGEN], 1u);
            else XB_SPIN(xb_ld(&bar[XB_TOPGEN]) == tg, bar);
            __builtin_amdgcn_fence(__ATOMIC_ACQUIRE, "agent");
            xb_add(&bar[XB_XGEN(b.x)], 1u);
            asm volatile("s_waitcnt vmcnt(0)" ::: "memory");
        } else {
            XB_SPIN(xb_ld(&bar[XB_XGEN(b.x)]) == gen, bar);
            __builtin_amdgcn_fence(__ATOMIC_ACQUIRE, "agent");
            asm volatile("s_waitcnt vmcnt(0)" ::: "memory");
        }
    }
    __syncthreads();
}

constexpr int NWAVES = 8;
#ifndef MK_N_LAUNCHES
#define MK_N_LAUNCHES 8
#endif
constexpr int PER_PHASE = 8;
constexpr int N_LAUNCHES = MK_N_LAUNCHES;

constexpr int BATCH = 4, T = 4096, D = 1024, M = BATCH * T;
constexpr int NHEAD = 8, HD = 64, TOPK = 256;
constexpr int D_IN = 4680, NPROJ = 4864;
constexpr int C_CB = 0, C_CC = 512, C_CU = 1024, C_CZ = 1536, C_Q = 2048, C_K = 2560, C_V = 3072, C_AZ = 3584, C_IQ = 4096, C_IK = 4608, C_IW = 4672;
constexpr float EPS = 1e-6f;
constexpr float C2 = 0.125f * 1.4426950408889634f;
constexpr float IWSCALE = 0.35355339059327373f * 0.125f;

constexpr size_t MiB = 1u << 20;
constexpr size_t WS_CTL = 0, CTL_ZERO_BYTES = 1 * MiB;
constexpr size_t WS_ROPE = 1 * MiB;
constexpr size_t WS_IW = 2 * MiB;
constexpr size_t WS_WIN = 4 * MiB;
constexpr size_t WS_WOUT = 14 * MiB;
constexpr size_t WS_H = 16 * MiB;
constexpr size_t WS_PROJ = 48 * MiB;
constexpr size_t WS_MASK = 200 * MiB;
constexpr size_t WS_YCAT = 208 * MiB;
constexpr size_t WS_END = 240 * MiB;
constexpr int CW_TMO = 0, CW_CODE = 1, CW_BAR = 4096, CW_MOD = 131072;
static_assert((CW_MOD + BATCH * 3 * D) * 4 <= (int)CTL_ZERO_BYTES, "ctl map");

constexpr int RING_OFF = 0, RING_BYTES = 147456;
constexpr int LDSCTL_OFF = RING_BYTES, MISC_OFF = LDSCTL_OFF + 320;
constexpr int LDS_BYTES = RING_BYTES + 1024;

typedef unsigned short u16;
__device__ __forceinline__ float bf2f(u16 v) { return __uint_as_float((unsigned)v << 16); }
__device__ __forceinline__ float h2f(u16 v) { return (float)__builtin_bit_cast(_Float16, v); }
__device__ __forceinline__ u16 f2h(float f) { return __builtin_bit_cast(u16, (_Float16)f); }
__device__ __forceinline__ unsigned pk2h(float lo, float hi) { return (unsigned)f2h(lo) | ((unsigned)f2h(hi) << 16); }
__device__ __forceinline__ float siluf(float z) { return z / (1.f + __expf(-z)); }

struct Args { const void* in[13]; float* out; unsigned char* ws; float if0, if1, if2, if3, if4, if5, if6, if7; int ph_lo, ph_hi; };
struct Frame {
    LAS unsigned char* lds;
    volatile LAS unsigned* MISC;
    gu32* ctl;
    int tid, lane, wave, vcu, G;
    const float *x, *c, *w_ada, *b_ada, *norm_in, *w_in, *conv_w, *conv_b, *gn_conv, *gn_attn, *w_out, *norm_f; const int* positions;
    float* out; float* MOD; float* ROPE; float* IW;
    u16 *WIN, *WOUT, *H, *PROJ, *YCAT; unsigned* MASK;
};
__device__ __forceinline__ float wave_sum(float v) {
#pragma unroll
    for (int o = 1; o < 64; o <<= 1) v += __shfl_xor(v, o);
    return v;
}
__device__ __forceinline__ int wave_sum_i(int v) {
#pragma unroll
    for (int o = 1; o < 64; o <<= 1) v += __shfl_xor(v, o);
    return v;
}
__device__ __forceinline__ float wave_max(float v) {
#pragma unroll
    for (int o = 1; o < 64; o <<= 1) v = fmaxf(v, __shfl_xor(v, o));
    return v;
}
__device__ __forceinline__ void p0_transpose_item(const float* W, int K, int N, int Npad, u16* WT, LAS float* scr, int item, int lane) {
    const int nblk = Npad / 32, kb = item / nblk, nb = item % nblk, k0 = 64 * kb, n0 = 32 * nb;
    const int n_in = n0 + (lane & 31);
#pragma unroll 8
    for (int i = 0; i < 32; ++i) { const int kk = 2 * i + (lane >> 5); scr[kk * 33 + (lane & 31)] = (n_in < N) ? W[(size_t)(k0 + kk) * N + n_in] : 0.f; }
    LDS_WAIT(); asm volatile("" ::: "memory");
    const int c = lane & 7;
#pragma unroll
    for (int j = 0; j < 4; ++j) { const int n = (lane >> 3) + 8 * j; const LAS float* s = scr + (8 * c) * 33 + n;
        v4u o; o.x = pk2h(s[0 * 33], s[1 * 33]); o.y = pk2h(s[2 * 33], s[3 * 33]); o.z = pk2h(s[4 * 33], s[5 * 33]); o.w = pk2h(s[6 * 33], s[7 * 33]);
        *(GAS v4u*)(WT + (size_t)(n0 + n) * K + k0 + 8 * c) = o; }
    LDS_WAIT(); asm volatile("" ::: "memory");
}
__device__ __forceinline__ void sincos_acc(float ang, float& sn, float& cs) {
    double rev = (double)ang * 0.15915494309189535; rev -= floor(rev);
    const int q = (int)(rev * 4.0 + 0.5);
    const float th = (float)((rev - 0.25 * (double)q) * 6.283185307179586);
    const float t2 = th * th;
    const float s = th * (1.f + t2 * (-1.f / 6.f + t2 * (1.f / 120.f + t2 * (-1.f / 5040.f + t2 * (1.f / 362880.f)))));
    const float c = 1.f + t2 * (-0.5f + t2 * (1.f / 24.f + t2 * (-1.f / 720.f + t2 * (1.f / 40320.f))));
    switch (q & 3) { case 0: sn = s; cs = c; break; case 1: sn = c; cs = -s; break; case 2: sn = -s; cs = -c; break; default: sn = -c; cs = s; break; }
}

__device__ __forceinline__ void p0_prologue(Frame& F, const Args& A) {
    LAS float* scr = (LAS float*)(F.lds + RING_OFF + F.wave * 16384);
    const int gw = F.vcu * NWAVES + F.wave, NGW = F.G * NWAVES;
    constexpr int I_IN = (D / 64) * (NPROJ / 32), I_OUT = (D / 64) * (D / 32), I_MOD = 32 * 48;
    constexpr int NITEMS = I_IN + I_OUT + I_MOD;
    for (int it = gw; it < NITEMS; it += NGW) {
        int r = it;
        if (r < I_IN) { p0_transpose_item(F.w_in, D, D_IN, NPROJ, F.WIN, scr, r, F.lane); continue; } r -= I_IN;
        if (r < I_OUT) { p0_transpose_item(F.w_out, D, D, D, F.WOUT, scr, r, F.lane); continue; } r -= I_OUT;
        {
            const int kc = r / 48, cg = r % 48, col = cg * 64 + F.lane;
            float sv[BATCH];
#pragma unroll
            for (int b = 0; b < BATCH; ++b) sv[b] = siluf(F.c[b * D + kc * 32 + (F.lane & 31)]);
            float acc[BATCH];
#pragma unroll
            for (int b = 0; b < BATCH; ++b) acc[b] = (kc == 0) ? F.b_ada[col] : 0.f;
#pragma unroll 8
            for (int kk = 0; kk < 32; ++kk) { const float wv = F.w_ada[(size_t)(kc * 32 + kk) * (3 * D) + col];
#pragma unroll
                for (int b = 0; b < BATCH; ++b) acc[b] += __shfl(sv[b], kk) * wv; }
#pragma unroll
            for (int b = 0; b < BATCH; ++b) atomicAdd(F.MOD + b * 3 * D + col, acc[b]);
        }
    }
    const int ri = F.lane & 7;
    const float ifr = ri == 0 ? A.if0 : ri == 1 ? A.if1 : ri == 2 ? A.if2 : ri == 3 ? A.if3 : ri == 4 ? A.if4 : ri == 5 ? A.if5 : ri == 6 ? A.if6 : A.if7;
    for (int e = (gw * 64 + F.lane); e < M * 8; e += NGW * 64) { const int m = e >> 3, i = e & 7;
        const float ang = (float)F.positions[m] * ifr; float sn, cs; sincos_acc(ang, sn, cs);
        F.ROPE[m * 16 + i] = cs; F.ROPE[m * 16 + 8 + i] = sn; }
}
__device__ __forceinline__ void p1_rows(Frame& F) {
    const int gw = F.vcu * NWAVES + F.wave, NGW = F.G * NWAVES;
    for (int m = gw; m < M; m += NGW) {
        const int b = m / T;
        const GAS f32x4* xr = (const GAS f32x4*)(F.x + (size_t)m * D) + F.lane;
        f32x4 v[4]; float s = 0.f;
#pragma unroll
        for (int j = 0; j < 4; ++j) { v[j] = xr[64 * j]; s += (v[j].x * v[j].x + v[j].y * v[j].y) + (v[j].z * v[j].z + v[j].w * v[j].w); }
        const float inv = 1.f / sqrtf(wave_sum(s) * (1.f / D) + EPS);
        GAS unsigned long long* o8 = (GAS unsigned long long*)(F.H + (size_t)m * D) + F.lane;
#pragma unroll
        for (int j = 0; j < 4; ++j) { const int col = 4 * F.lane + 256 * j;
            const f32x4 g = *(const f32x4*)(F.norm_in + col), sh = *(const f32x4*)(F.MOD + b * 3 * D + col), sc = *(const f32x4*)(F.MOD + b * 3 * D + D + col);
            const f32x4 h = (v[j] * inv) * g * (sc + 1.f) + sh;
            o8[64 * j] = (unsigned long long)pk2h(h.x, h.y) | ((unsigned long long)pk2h(h.z, h.w) << 32); }
    }
}
__device__ __forceinline__ void p3_rows(Frame& F) {
    const int gw = F.vcu * NWAVES + F.wave, NGW = F.G * NWAVES, lane = F.lane;
    for (int m = gw; m < M; m += NGW) {
        const int t = m % T;
        u16* prow = F.PROJ + (size_t)m * NPROJ;
        const int h = lane >> 3, i = lane & 7;
        const float cs = F.ROPE[m * 16 + i], sn = F.ROPE[m * 16 + 8 + i];
        { u16* p = prow + C_Q + h * 64; const float x1 = bf2f(p[i]), x2 = bf2f(p[8 + i]); p[i] = (u16)f2bf(x1 * cs - x2 * sn); p[8 + i] = (u16)f2bf(x1 * sn + x2 * cs); }
        { u16* p = prow + C_K + h * 64; const float x1 = bf2f(p[i]), x2 = bf2f(p[8 + i]); p[i] = (u16)f2bf(x1 * cs - x2 * sn); p[8 + i] = (u16)f2bf(x1 * sn + x2 * cs); }
        { u16* p = prow + C_IQ + h * 64; const float x1 = h2f(p[i]), x2 = h2f(p[8 + i]); p[i] = f2h(x1 * cs - x2 * sn); p[8 + i] = f2h(x1 * sn + x2 * cs); }
        if (h == 0) { u16* p = prow + C_IK; const float x1 = h2f(p[i]), x2 = h2f(p[8 + i]); p[i] = f2h(x1 * cs - x2 * sn); p[8 + i] = f2h(x1 * sn + x2 * cs); }
        const int c0 = lane * 8;
        const v4u z4 = {0u, 0u, 0u, 0u};
        const v4u cbv = *(const v4u*)(prow + C_CB + c0), czv = *(const v4u*)(prow + C_CZ + c0);
        const v4u cc0 = *(const v4u*)(prow + C_CC + c0), cu0 = *(const v4u*)(prow + C_CU + c0);
        const v4u cc1 = t >= 1 ? *(const v4u*)(prow - NPROJ + C_CC + c0) : z4, cu1 = t >= 1 ? *(const v4u*)(prow - NPROJ + C_CU + c0) : z4;
        const v4u cc2 = t >= 2 ? *(const v4u*)(prow - 2 * NPROJ + C_CC + c0) : z4, cu2 = t >= 2 ? *(const v4u*)(prow - 2 * NPROJ + C_CU + c0) : z4;
        float y[8]; float ss = 0.f;
#pragma unroll
        for (int e = 0; e < 8; ++e) {
            const int wd = e >> 1; const bool hi = e & 1;
#define UNP(v) (hi ? __uint_as_float((v)[wd] & 0xffff0000u) : __uint_as_float((v)[wd] << 16))
            const float s0 = UNP(cc0) * UNP(cu0), s1 = UNP(cc1) * UNP(cu1), s2 = UNP(cc2) * UNP(cu2);
            const int c = c0 + e;
            const float cv = F.conv_b[c] + F.conv_w[c] * s2 + F.conv_w[512 + c] * s1 + F.conv_w[1024 + c] * s0;
            y[e] = UNP(cbv) * cv; ss += y[e] * y[e];
        }
        ss += __shfl_xor(ss, 1); ss += __shfl_xor(ss, 2); ss += __shfl_xor(ss, 4);
        const float inv = 1.f / sqrtf(ss * (1.f / 64.f) + EPS);
        float o[8];
#pragma unroll
        for (int e = 0; e < 8; ++e) { const int wd = e >> 1; const bool hi = e & 1; o[e] = y[e] * inv * F.gn_conv[c0 + e] * siluf(UNP(czv)); }
#undef UNP
        v4u ov; ov.x = pk2h(o[0], o[1]); ov.y = pk2h(o[2], o[3]); ov.z = pk2h(o[4], o[5]); ov.w = pk2h(o[6], o[7]);
        *(v4u*)(F.YCAT + (size_t)m * D + c0) = ov;
    }
}
__device__ __forceinline__ unsigned okey(float s) { const unsigned u = __float_as_uint(s); return (u & 0x80000000u) ? ~u : (u | 0x80000000u); }
__device__ __forceinline__ void p4_indexer(Frame& F) {
    const int gw = F.vcu * NWAVES + F.wave, NGW = F.G * NWAVES, lane = F.lane;
    LAS float* iqf = (LAS float*)(F.lds + RING_OFF + F.wave * 18432);
    LAS float* sc = iqf + 512;
    for (int m = gw; m < M; m += NGW) {
        const int b = m / T, t = m % T, n = t + 1;
        unsigned* mrow = F.MASK + (size_t)m * 128;
        if (n <= TOPK) {
            for (int w = lane; w < 128; w += 64) { const int k0 = 32 * w; mrow[w] = (k0 + 31 <= t) ? 0xffffffffu : (k0 > t ? 0u : ((1u << (t - k0 + 1)) - 1u)); }
            continue;
        }
        const u16* prow = F.PROJ + (size_t)m * NPROJ;
        for (int e = lane; e < 512; e += 64) iqf[e] = h2f(prow[C_IQ + e]);
        const float wv = (lane < 8) ? F.IW[m * 8 + lane] : 0.f;
        float wh[8];
#pragma unroll
        for (int h = 0; h < 8; ++h) wh[h] = __shfl(wv, h);
        LDS_WAIT(); asm volatile("" ::: "memory");
        for (int s = lane; s < n; s += 64) {
            const v4u* kr = (const v4u*)(F.PROJ + (size_t)(b * T + s) * NPROJ + C_IK);
            float kf[64];
#pragma unroll
            for (int q = 0; q < 8; ++q) { const v4u v = kr[q];
#pragma unroll
                for (int e = 0; e < 4; ++e) { const unsigned w = v[e]; kf[q * 8 + 2 * e] = h2f((u16)(w & 0xffffu)); kf[q * 8 + 2 * e + 1] = h2f((u16)(w >> 16)); } }
            float score = 0.f;
#pragma unroll
            for (int h = 0; h < 8; ++h) { float d = 0.f;
#pragma unroll
                for (int dd = 0; dd < 64; ++dd) d = fmaf(iqf[h * 64 + dd], kf[dd], d);
                score = fmaf(wh[h], fmaxf(d, 0.f), score); }
            sc[s] = score;
        }
        LDS_WAIT(); asm volatile("" ::: "memory");
        unsigned keys[64];
#pragma unroll
        for (int j = 0; j < 64; ++j) { const int s = j * 64 + lane; keys[j] = (s < n) ? okey(sc[s]) : 0u; }
        unsigned Tk = 0u;
        for (int bit = 31; bit >= 0; --bit) { const unsigned cand = Tk | (1u << bit); int c = 0;
#pragma unroll
            for (int j = 0; j < 64; ++j) c += (keys[j] >= cand) ? 1 : 0;
            c = wave_sum_i(c); if (c >= TOPK) Tk = cand; }
        int cgt = 0;
#pragma unroll
        for (int j = 0; j < 64; ++j) cgt += (keys[j] > Tk) ? 1 : 0;
        cgt = wave_sum_i(cgt);
        const int need = TOPK - cgt; int base = 0;
        const unsigned long long ltm = (1ull << lane) - 1ull;
#pragma unroll
        for (int j = 0; j < 64; ++j) {
            const bool tie = keys[j] == Tk; const unsigned long long bl = __ballot(tie);
            const int rank = base + __popcll(bl & ltm);
            const bool sel = (keys[j] > Tk) || (tie && rank < need); base += __popcll(bl);
            const unsigned long long sb = __ballot(sel);
            if (lane == 0) { mrow[2 * j] = (unsigned)sb; mrow[2 * j + 1] = (unsigned)(sb >> 32); }
        }
        LDS_WAIT(); asm volatile("" ::: "memory");
    }
}
__device__ __forceinline__ void p5_attn(Frame& F) {
    const int gw = F.vcu * NWAVES + F.wave, NGW = F.G * NWAVES, lane = F.lane;
    LAS int* idx = (LAS int*)(F.lds + RING_OFF + F.wave * 4096);
    LAS float* qf = (LAS float*)(idx + 256);
    LAS float* pl = qf + 64;
    const unsigned long long ltm = (1ull << lane) - 1ull;
    for (int m = gw; m < M; m += NGW) {
        const int b = m / T, t = m % T;
        const unsigned* mrow = F.MASK + (size_t)m * 128;
        int base = 0;
        for (int j = 0; j <= (t >> 6); ++j) {
            const unsigned long long bm = (unsigned long long)mrow[2 * j] | ((unsigned long long)mrow[2 * j + 1] << 32);
            const bool sel = (bm >> lane) & 1ull; const int pos = base + __popcll(bm & ltm);
            if (sel && pos < TOPK) idx[pos] = j * 64 + lane;
            base += __popcll(bm);
        }
        const int nsel = base < TOPK ? base : TOPK;
        const u16* prow = F.PROJ + (size_t)m * NPROJ;
        for (int h = 0; h < NHEAD; ++h) {
            qf[lane] = bf2f(prow[C_Q + h * 64 + lane]);
            LDS_WAIT(); asm volatile("" ::: "memory");
            float lg[4]; float mx = -INFINITY;
#pragma unroll
            for (int c = 0; c < 4; ++c) { const int p = c * 64 + lane; lg[c] = -INFINITY;
                if (p < nsel) { const int s = idx[p]; const v4u* kr = (const v4u*)(F.PROJ + (size_t)(b * T + s) * NPROJ + C_K + h * 64); float d = 0.f;
#pragma unroll
                    for (int q = 0; q < 8; ++q) { const v4u v = kr[q];
#pragma unroll
                        for (int e = 0; e < 4; ++e) { d = fmaf(qf[q * 8 + 2 * e], __uint_as_float(v[e] << 16), d); d = fmaf(qf[q * 8 + 2 * e + 1], __uint_as_float(v[e] & 0xffff0000u), d); } }
                    lg[c] = d; }
                mx = fmaxf(mx, lg[c]); }
            mx = wave_max(mx);
            float sum = 0.f;
#pragma unroll
            for (int c = 0; c < 4; ++c) { const int p = c * 64 + lane; const float pe = (p < nsel) ? exp2f(lg[c] - mx) : 0.f; sum += pe; pl[p] = pe; }
            sum = wave_sum(sum);
            LDS_WAIT(); asm volatile("" ::: "memory");
            float acc = 0.f;
            const u16* vb = F.PROJ + (size_t)(b * T) * NPROJ + C_V + h * 64 + lane;
#pragma unroll 4
            for (int p = 0; p < nsel; ++p) acc = fmaf(pl[p], bf2f(vb[(size_t)idx[p] * NPROJ]), acc);
            const float o = acc / sum;
            const float ssq = wave_sum(o * o);
            const float y = o * (1.f / sqrtf(ssq * (1.f / 64.f) + EPS)) * F.gn_attn[h * 64 + lane] * siluf(bf2f(prow[C_AZ + h * 64 + lane]));
            F.YCAT[(size_t)m * D + 512 + h * 64 + lane] = f2h(y);
            LDS_WAIT(); asm volatile("" ::: "memory");
        }
    }
}
__device__ __forceinline__ void p7_rows(Frame& F) {
    const int gw = F.vcu * NWAVES + F.wave, NGW = F.G * NWAVES;
    for (int m = gw; m < M; m += NGW) {
        GAS f32x4* xr = (GAS f32x4*)(F.out + (size_t)m * D) + F.lane;
        f32x4 v[4]; float s = 0.f;
#pragma unroll
        for (int j = 0; j < 4; ++j) { v[j] = xr[64 * j]; s += (v[j].x * v[j].x + v[j].y * v[j].y) + (v[j].z * v[j].z + v[j].w * v[j].w); }
        const float inv = 1.f / sqrtf(wave_sum(s) * (1.f / D) + EPS);
#pragma unroll
        for (int j = 0; j < 4; ++j) { const f32x4 g = *(const f32x4*)(F.norm_f + 4 * F.lane + 256 * j); xr[64 * j] = (v[j] * inv) * g; }
    }
}

__global__ void __launch_bounds__(NWAVES * 64, 2) fwd_kernel(Args args) {
    extern __shared__ __attribute__((aligned(16))) unsigned char lds[];
    Frame F;
    F.lds = (LAS unsigned char*)lds;
    F.MISC = (volatile LAS unsigned*)(F.lds + MISC_OFF);
    F.tid = threadIdx.x; F.lane = F.tid & 63; F.wave = __builtin_amdgcn_readfirstlane(F.tid >> 6);
    F.G = gridDim.x; { const int bx = blockIdx.x; F.vcu = (F.G % 8 == 0) ? (bx % 8) * (F.G / 8) + bx / 8 : bx; }
    unsigned char* ws = args.ws;
    F.ctl = (gu32*)(ws + WS_CTL);
    F.x = (const float*)args.in[0]; F.c = (const float*)args.in[1]; F.positions = (const int*)args.in[2]; F.w_ada = (const float*)args.in[3]; F.b_ada = (const float*)args.in[4];
    F.norm_in = (const float*)args.in[5]; F.w_in = (const float*)args.in[6]; F.conv_w = (const float*)args.in[7]; F.conv_b = (const float*)args.in[8];
    F.gn_conv = (const float*)args.in[9]; F.gn_attn = (const float*)args.in[10]; F.w_out = (const float*)args.in[11]; F.norm_f = (const float*)args.in[12];
    F.out = args.out;
    F.MOD = (float*)(ws + WS_CTL) + CW_MOD; F.ROPE = (float*)(ws + WS_ROPE); F.IW = (float*)(ws + WS_IW);
    F.WIN = (u16*)(ws + WS_WIN); F.WOUT = (u16*)(ws + WS_WOUT); F.H = (u16*)(ws + WS_H); F.PROJ = (u16*)(ws + WS_PROJ); F.YCAT = (u16*)(ws + WS_YCAT); F.MASK = (unsigned*)(ws + WS_MASK);
    for (int u = F.tid; u < (LDS_BYTES - LDSCTL_OFF) / 4; u += NWAVES * 64) ((LAS unsigned*)(F.lds + LDSCTL_OFF))[u] = 0u;
    __syncthreads();
    XcdBarrier bar; bar.bar = (unsigned*)(F.ctl + CW_BAR); bar.x = 0; bar.st = nullptr;
    if (N_LAUNCHES != PER_PHASE) bar = xcd_barrier_post((unsigned*)(F.ctl + CW_BAR), F.MISC + 8);
#define GRID_BAR(seam) do { if (N_LAUNCHES == PER_PHASE) { if (F.tid == 0) __hip_atomic_store(F.ctl + CW_TMO, 0xBADBA0u | (unsigned)(seam), RLX_AGENT); } else { xcd_barrier(bar); } } while (0)
    const int lo = args.ph_lo, hi = args.ph_hi;
#define IN(k) (lo <= (k) && (k) < hi)
#define BOTH(k) (IN(k) && IN((k) + 1))
    if (IN(0)) { p0_prologue(F, args); if (BOTH(0)) GRID_BAR(0); }
    if (IN(1)) { p1_rows(F); if (BOTH(1)) GRID_BAR(1); }
    if (IN(2)) {
        pg8::Gemm g{F.H, F.WIN, M, NPROJ, D}; pg8::StaticOrder S; S.init(M, NPROJ, F.G, (int)blockIdx.x);
        pg8::EpiProj E{F.PROJ, NPROJ, F.IW, C2, IWSCALE};
        pg8::gemm_phase<pg8::EpiProj, pg8::StaticOrder, true, true, true>(F.lds + RING_OFF, g, S, E);
        if (BOTH(2)) GRID_BAR(2);
    }
    if (IN(3)) { p3_rows(F); if (BOTH(3)) GRID_BAR(3); }
    if (IN(4)) { p4_indexer(F); if (BOTH(4)) GRID_BAR(4); }
    if (IN(5)) { p5_attn(F); if (BOTH(5)) GRID_BAR(5); }
    if (IN(6)) {
        pg8::Gemm g{F.YCAT, F.WOUT, M, D, D}; pg8::StaticOrder S; S.init(M, D, F.G, (int)blockIdx.x);
        pg8::EpiOut E{F.x, F.out, D, F.MOD + 2 * D, 3 * D, T};
        pg8::gemm_phase<pg8::EpiOut, pg8::StaticOrder, false, true, true>(F.lds + RING_OFF, g, S, E);
        if (BOTH(6)) GRID_BAR(6);
    }
    if (IN(7)) { p7_rows(F); }
#undef IN
#undef BOTH
}

extern "C" void kernel_launch(void* const* d_in, const int* in_sizes, int n_in, void* d_out, int out_size, void* d_ws, size_t ws_size, hipStream_t stream) {
    static int grid = 0;
    if (grid == 0) {
        if (n_in != 13 || in_sizes[0] != M * D || out_size != M * D || ws_size < WS_END) { fprintf(stderr, "kernel_launch: unexpected shapes (n_in %d, in0 %d, out %d, ws %zu); nothing launched\n", n_in, n_in > 0 ? in_sizes[0] : -1, out_size, ws_size); grid = -1; return; }
        int dev = 0, cus = 0, per_cu = 0;
        if (hipGetDevice(&dev) != hipSuccess || hipDeviceGetAttribute(&cus, hipDeviceAttributeMultiprocessorCount, dev) != hipSuccess) { grid = -1; return; }
        if (hipFuncSetAttribute((const void*)fwd_kernel, hipFuncAttributeMaxDynamicSharedMemorySize, LDS_BYTES) != hipSuccess) { fprintf(stderr, "kernel_launch: hipFuncSetAttribute failed\n"); grid = -1; return; }
        if (hipOccupancyMaxActiveBlocksPerMultiprocessor(&per_cu, (const void*)fwd_kernel, NWAVES * 64, LDS_BYTES) != hipSuccess || per_cu < 1)
            fprintf(stderr, "kernel_launch: note: occupancy query reports %d workgroups per CU\n", per_cu);
        (void)hipGetLastError();
        grid = cus;
    }
    if (grid < 0) return;
    if (hipMemsetAsync((char*)d_ws + WS_CTL, 0, CTL_ZERO_BYTES, stream) != hipSuccess) return;
    Args a{};
    for (int i = 0; i < 13; ++i) a.in[i] = d_in[i];
    a.out = (float*)d_out; a.ws = (unsigned char*)d_ws;
    { float f[8]; for (int i = 0; i < 8; ++i) f[i] = (float)pow(500000.0, -(double)i / 8.0); a.if0 = f[0]; a.if1 = f[1]; a.if2 = f[2]; a.if3 = f[3]; a.if4 = f[4]; a.if5 = f[5]; a.if6 = f[6]; a.if7 = f[7]; }
    for (int li = 0; li < N_LAUNCHES; ++li) {
        a.ph_lo = (N_LAUNCHES == PER_PHASE) ? li : 0; a.ph_hi = (N_LAUNCHES == PER_PHASE) ? li + 1 : PER_PHASE;
        hipLaunchKernelGGL(fwd_kernel, dim3(grid), dim3(NWAVES * 64), LDS_BYTES, stream, a);
        const hipError_t le = hipPeekAtLastError();
        if (le != hipSuccess) { fprintf(stderr, "kernel_launch: launch %d failed: %s\n", li, hipGetErrorName(le)); break; }
    }
}
```

```cpp
#include <hip/hip_runtime.h>
#include <cstdio>
#include <cstdint>
#include <cmath>
namespace pg8 {
#define PG8_LAS __attribute__((address_space(3)))
typedef unsigned short bf16_t;
typedef short bf16x8 __attribute__((ext_vector_type(8)));
typedef float f32x4 __attribute__((ext_vector_type(4)));
typedef unsigned u32x4 __attribute__((ext_vector_type(4)));
constexpr int BM = 256, BK = 64, HALF = 128, HTB = HALF * BK * 2  , STAGE_BYTES = 8 * HTB, NXCD = 8, WGM = 8;

__host__ __device__ __forceinline__ int lds_byte(int r, int c) { const int st = (r >> 4) * 2 + (c >> 5), rr = r & 15, cc = c & 31, ob = rr * 64 + cc * 2; return st * 1024 + (ob ^ (((ob >> 9) & 1) << 5)); }
__host__ __device__ __forceinline__ void stage_rc(int b, int& R, int& C) { const int st = b / 1024, sb = b % 1024, swz = sb ^ (((sb >> 9) & 1) << 5); R = (st >> 1) * 16 + swz / 64; C = (st & 1) * 32 + (swz % 64) / 2; }
__host__ __device__ __forceinline__ int perm32(int rho) { const int n = rho >> 4, i = rho & 15; return 8 * (i >> 2) + 4 * n + (i & 3); }

struct Unit { int pm, pn; };
struct Gemm { const bf16_t* A; const bf16_t* Bt; int M, N, K; };

struct StaticOrder {
    int nM, nN, nwg, G, c;
    __host__ __device__ void init(int M, int N, int G_, int c_) { nM = M / BM; nN = N / BM; nwg = nM * nN; G = G_; c = c_; }
    __host__ __device__ bool next(int i, Unit& u) const {
        const long L = (long)i * G + c; if (L >= nwg) return false;
        int wgid = (int)L; { const int q = nwg / NXCD, r = nwg % NXCD, xcd = wgid % NXCD, off = wgid / NXCD; wgid = (xcd < r ? xcd * (q + 1) : r * (q + 1) + (xcd - r) * q) + off; }
        const int nig = WGM * nN, gid = wgid / nig, fm = gid * WGM, gsz = (nM - fm) < WGM ? (nM - fm) : WGM;
        u.pm = fm + ((wgid % nig) % gsz); u.pn = (wgid % nig) / gsz; return true;
    }
    __device__ __forceinline__ void a_ready(const Unit&) const {}
    __device__ __forceinline__ void done(const Unit&) const {}
};

__device__ __forceinline__ unsigned cvt_pk_bf16(float lo, float hi) { unsigned r; asm volatile("v_cvt_pk_bf16_f32 %0, %1, %2" : "=v"(r) : "v"(lo), "v"(hi)); return r; }
typedef float f32x2 __attribute__((ext_vector_type(2)));
typedef _Float16 f16x8 __attribute__((ext_vector_type(8)));
typedef _Float16 f16x2 __attribute__((ext_vector_type(2)));
__device__ __forceinline__ unsigned cvt_pk_f16(float lo, float hi) { f16x2 v = {(_Float16)lo, (_Float16)hi}; return __builtin_bit_cast(unsigned, v); }
template <bool F16> __device__ __forceinline__ f32x4 mma16(bf16x8 a, bf16x8 b, f32x4 c) {
    if constexpr (F16) return __builtin_amdgcn_mfma_f32_16x16x32_f16(__builtin_bit_cast(f16x8, a), __builtin_bit_cast(f16x8, b), c, 0, 0, 0);
    else return __builtin_amdgcn_mfma_f32_16x16x32_bf16(a, b, c, 0, 0, 0);
}

struct EpiProj {
    static constexpr bool PERM = true, AFTER_DRAIN = false;
    bf16_t* O; int ldc; float* IW; float qscale, iwscale;
    __device__ __forceinline__ void operator()(const f32x4 (&acc)[2][2][4][2], const Unit& u, int wr, int wc, int fr, int fq) const {
        const int row0 = u.pm * BM + wr * 64 + fr; const int col0 = u.pn * BM + wc * 32 + 8 * fq;
        const float sc = (u.pn == 8 || u.pn == 9) ? qscale : 1.f; const bool h16 = u.pn >= 16;
#pragma unroll
        for (int ai = 0; ai < 2; ++ai)
#pragma unroll
            for (int m = 0; m < 4; ++m) { const int row = row0 + ai * HALF + m * 16; bf16_t* rowp = O + (size_t)row * ldc + col0;
#pragma unroll
                for (int bj = 0; bj < 2; ++bj) { const f32x4 v0 = acc[ai][bj][m][0] * sc, v1 = acc[ai][bj][m][1] * sc; u32x4 w;
                    if (h16) { w.x = cvt_pk_f16(v0[0], v0[1]); w.y = cvt_pk_f16(v0[2], v0[3]); w.z = cvt_pk_f16(v1[0], v1[1]); w.w = cvt_pk_f16(v1[2], v1[3]); }
                    else { w.x = cvt_pk_bf16(v0[0], v0[1]); w.y = cvt_pk_bf16(v0[2], v0[3]); w.z = cvt_pk_bf16(v1[0], v1[1]); w.w = cvt_pk_bf16(v1[2], v1[3]); }
                    *(u32x4*)(rowp + bj * HALF) = w;
                    if (bj == 0 && u.pn == 18 && wc == 2 && fq == 0) { float* ip = IW + (size_t)row * 8; *(f32x4*)ip = v0 * iwscale; *(f32x4*)(ip + 4) = v1 * iwscale; } } }
    }
};
struct EpiOut {
    static constexpr bool PERM = false, AFTER_DRAIN = false;
    const float* x; float* out; int ldc; const float* gate; int gstride; int rows_per_batch;
    __device__ __forceinline__ void operator()(const f32x4 (&acc)[2][2][4][2], const Unit& u, int wr, int wc, int fr, int fq) const {
        const int row0 = u.pm * BM + wr * 64 + fr; const int col0 = u.pn * BM + wc * 32 + 4 * fq;
        const float* g = gate + (size_t)((u.pm * BM) / rows_per_batch) * gstride;
        f32x4 gv[2][2];
#pragma unroll
        for (int bj = 0; bj < 2; ++bj)
#pragma unroll
            for (int n = 0; n < 2; ++n) gv[bj][n] = *(const f32x4*)(g + col0 + bj * HALF + n * 16);
#pragma unroll
        for (int ai = 0; ai < 2; ++ai)
#pragma unroll
            for (int m = 0; m < 4; ++m) { const size_t off = (size_t)(row0 + ai * HALF + m * 16) * ldc + col0;
#pragma unroll
                for (int bj = 0; bj < 2; ++bj)
#pragma unroll
                    for (int n = 0; n < 2; ++n) { const f32x4 xv = *(const f32x4*)(x + off + bj * HALF + n * 16);
                        *(f32x4*)(out + off + bj * HALF + n * 16) = xv + gv[bj][n] * acc[ai][bj][m][n]; } }
    }
};

template <class Epi, class Sched, bool ALIGN_EPI = false, bool SP2 = false, bool F16 = false>
__device__ __forceinline__ void gemm_phase(PG8_LAS unsigned char* lds, const Gemm g, const Sched& S, const Epi& E) {
    const int tid = threadIdx.x, wid = __builtin_amdgcn_readfirstlane(tid >> 6), lane = tid & 63, wr = wid >> 2, wc = wid & 3, fr = lane & 15, fq = lane >> 4;
    const int K = g.K, nt = K / BK;
    unsigned voffA[2], voffB[2];
#pragma unroll
    for (int i = 0; i < 2; ++i) { int R, C; stage_rc(tid * 16 + i * 8192, R, C); const int Rb = Epi::PERM ? ((R & ~31) + perm32(R & 31)) : R;
        voffA[i] = (unsigned)(R * K + C) * 2u; voffB[i] = (unsigned)(Rb * K + C) * 2u; }
    const size_t kstep = (size_t)(BK * 2);
    const size_t hstep = (size_t)HALF * K * 2;
    const size_t tstep = 2 * hstep;
    const unsigned ldsw = (unsigned)wid * 1024u;
    const int aoff = lds_byte(wr * 64 + fr, fq * 8), boff = lds_byte(wc * 32 + fr, fq * 8);
#define PG8_SA(b, h) (((b) * 2 + (h)) * HTB)
#define PG8_SB(b, h) ((4 + (b) * 2 + (h)) * HTB)
#define PG8_STAGE(bufoff, gbase, voff) do { _Pragma("unroll") for (int _i = 0; _i < 2; ++_i) \
        __builtin_amdgcn_global_load_lds((const unsigned*)((const char*)(gbase) + (voff)[_i]), (PG8_LAS unsigned*)(lds + (bufoff) + ldsw + _i * 8192), 16, 0, 0); } while (0)
#define PG8_LDA(dst, b, h) do { _Pragma("unroll") for (int m = 0; m < 4; ++m) _Pragma("unroll") for (int k = 0; k < 2; ++k) dst[m][k] = *(const PG8_LAS bf16x8*)(lds + PG8_SA(b, h) + aoff + m * 2048 + k * 1024); } while (0)
#define PG8_LDB(dst, b, h) do { _Pragma("unroll") for (int n = 0; n < 2; ++n) _Pragma("unroll") for (int k = 0; k < 2; ++k) dst[n][k] = *(const PG8_LAS bf16x8*)(lds + PG8_SB(b, h) + boff + n * 2048 + k * 1024); } while (0)
#define PG8_MMA(ai, bj, At, Bt) do { __builtin_amdgcn_s_setprio(1); _Pragma("unroll") for (int m = 0; m < 4; ++m) _Pragma("unroll") for (int n = 0; n < 2; ++n) _Pragma("unroll") for (int k = 0; k < 2; ++k) \
        acc[ai][bj][m][n] = mma16<F16>(Bt[n][k], At[m][k], acc[ai][bj][m][n]); __builtin_amdgcn_s_setprio(0); } while (0)
#define PG8_WAIT_V(n) asm volatile("s_waitcnt vmcnt(" #n ")" ::: "memory")
#define PG8_WAIT_L(n) asm volatile("s_waitcnt lgkmcnt(" #n ")" ::: "memory")
#define PG8_BAR __builtin_amdgcn_s_barrier()
#define PG8_SCHED __builtin_amdgcn_sched_barrier(0)
    Unit cur, nxt; int ui = 0;
    if (!S.next(0, cur)) return;
    f32x4 acc[2][2][4][2];
#pragma unroll
    for (int a = 0; a < 2; ++a)
#pragma unroll
        for (int b = 0; b < 2; ++b)
#pragma unroll
            for (int m = 0; m < 4; ++m)
#pragma unroll
                for (int n = 0; n < 2; ++n) acc[a][b][m][n] = (f32x4){0.f, 0.f, 0.f, 0.f};
    bf16x8 At[4][2], B0[2][2], B1[2][2];
    const char* cA = (const char*)g.A + (size_t)cur.pm * tstep; const char* cB = (const char*)g.Bt + (size_t)cur.pn * tstep;
    S.a_ready(cur);
    if constexpr (SP2) {
        PG8_STAGE(PG8_SB(0, 0), cB, voffB); PG8_STAGE(PG8_SB(0, 1), cB + hstep, voffB); PG8_STAGE(PG8_SA(0, 0), cA, voffA); PG8_STAGE(PG8_SA(0, 1), cA + hstep, voffA);
        if (wr == 1) PG8_BAR;
        PG8_WAIT_V(2); PG8_BAR;
        PG8_STAGE(PG8_SB(1, 0), cB + kstep, voffB); PG8_STAGE(PG8_SA(1, 0), cA + kstep, voffA); PG8_STAGE(PG8_SB(1, 1), cB + hstep + kstep, voffB);
        PG8_WAIT_V(6); PG8_BAR;
    } else {
        PG8_STAGE(PG8_SB(0, 0), cB, voffB); PG8_STAGE(PG8_SA(0, 0), cA, voffA); PG8_STAGE(PG8_SB(0, 1), cB + hstep, voffB); PG8_STAGE(PG8_SA(0, 1), cA + hstep, voffA);
        if (wr == 1) PG8_BAR;
        PG8_WAIT_V(4); PG8_BAR;
        PG8_STAGE(PG8_SB(1, 0), cB + kstep, voffB); PG8_STAGE(PG8_SA(1, 0), cA + kstep, voffA); PG8_STAGE(PG8_SB(1, 1), cB + hstep + kstep, voffB);
        PG8_WAIT_V(6); PG8_BAR;
    }
    for (;;) {
        const bool has_next = S.next(ui + 1, nxt);
        const char* nA = has_next ? (const char*)g.A + (size_t)nxt.pm * tstep : cA; const char* nB = has_next ? (const char*)g.Bt + (size_t)nxt.pn * tstep : cB;
        for (int t = 0; t < nt; t += 2) {
            const bool last = (t == nt - 2);
            const char* a1 = cA + (size_t)(t + 1) * kstep;
            const char* a2 = last ? nA : cA + (size_t)(t + 2) * kstep; const char* b2 = last ? nB : cB + (size_t)(t + 2) * kstep;
            const char* a3 = a2 + kstep; const char* b3 = b2 + kstep;
            if (last && has_next) S.a_ready(nxt);
            if constexpr (SP2) {
            PG8_LDB(B0, 0, 0); PG8_LDB(B1, 0, 1); PG8_SCHED; PG8_LDA(At, 0, 0); PG8_STAGE(PG8_SA(1, 1), a1 + hstep, voffA);
            PG8_WAIT_V(8); PG8_WAIT_L(0); PG8_BAR; PG8_MMA(0, 0, At, B0); PG8_MMA(0, 1, At, B1); PG8_BAR; PG8_SCHED;
            PG8_LDA(At, 0, 1); PG8_STAGE(PG8_SB(0, 0), b2, voffB); PG8_STAGE(PG8_SB(0, 1), b2 + hstep, voffB); PG8_STAGE(PG8_SA(0, 0), a2, voffA);
            PG8_WAIT_V(8); PG8_WAIT_L(0); PG8_BAR; PG8_MMA(1, 0, At, B0); PG8_MMA(1, 1, At, B1); PG8_BAR; PG8_SCHED;
            PG8_LDB(B0, 1, 0); PG8_LDB(B1, 1, 1); PG8_SCHED; PG8_LDA(At, 1, 0); PG8_STAGE(PG8_SA(0, 1), a2 + hstep, voffA);
            PG8_WAIT_V(8); PG8_WAIT_L(0); PG8_BAR; PG8_MMA(0, 0, At, B0); PG8_MMA(0, 1, At, B1); PG8_BAR; PG8_SCHED;
            PG8_LDA(At, 1, 1); PG8_STAGE(PG8_SB(1, 0), b3, voffB); PG8_STAGE(PG8_SB(1, 1), b3 + hstep, voffB); PG8_STAGE(PG8_SA(1, 0), a3, voffA);
            PG8_WAIT_V(8); PG8_WAIT_L(0); PG8_BAR; PG8_MMA(1, 0, At, B0); PG8_MMA(1, 1, At, B1); PG8_BAR; PG8_SCHED;
            } else {
            PG8_LDB(B0, 0, 0); PG8_SCHED; PG8_LDA(At, 0, 0); PG8_STAGE(PG8_SA(1, 1), a1 + hstep, voffA);
            PG8_WAIT_L(8); PG8_BAR; PG8_WAIT_L(0); PG8_MMA(0, 0, At, B0); PG8_BAR; PG8_SCHED;
            PG8_LDB(B1, 0, 1); PG8_STAGE(PG8_SB(0, 0), b2, voffB);
            PG8_BAR; PG8_WAIT_L(0); PG8_MMA(0, 1, At, B1); PG8_BAR;
            PG8_LDA(At, 0, 1); PG8_STAGE(PG8_SA(0, 0), a2, voffA);
            PG8_BAR; PG8_WAIT_L(0); PG8_MMA(1, 0, At, B0); PG8_BAR; PG8_SCHED;
            PG8_STAGE(PG8_SB(0, 1), b2 + hstep, voffB);
            PG8_WAIT_V(6); PG8_BAR; PG8_MMA(1, 1, At, B1); PG8_BAR;
            PG8_LDB(B0, 1, 0); PG8_SCHED; PG8_LDA(At, 1, 0); PG8_STAGE(PG8_SA(0, 1), a2 + hstep, voffA);
            PG8_WAIT_L(8); PG8_BAR; PG8_WAIT_L(0); PG8_MMA(0, 0, At, B0); PG8_BAR; PG8_SCHED;
            PG8_LDB(B1, 1, 1); PG8_STAGE(PG8_SB(1, 0), b3, voffB);
            PG8_BAR; PG8_WAIT_L(0); PG8_MMA(0, 1, At, B1); PG8_BAR;
            PG8_LDA(At, 1, 1); PG8_STAGE(PG8_SA(1, 0), a3, voffA);
            PG8_BAR; PG8_WAIT_L(0); PG8_MMA(1, 0, At, B0); PG8_BAR; PG8_SCHED;
            PG8_STAGE(PG8_SB(1, 1), b3 + hstep, voffB);
            PG8_WAIT_V(6); PG8_BAR; PG8_MMA(1, 1, At, B1); PG8_BAR;
            }
        }
        if constexpr (ALIGN_EPI) { if (wr == 0) PG8_BAR; }
        if constexpr (!Epi::AFTER_DRAIN) { E(acc, cur, wr, wc, fr, fq); S.done(cur); }
        if (!has_next) break;
#pragma unroll
        for (int a = 0; a < 2; ++a)
#pragma unroll
            for (int b = 0; b < 2; ++b)
#pragma unroll
                for (int m = 0; m < 4; ++m)
#pragma unroll
                    for (int n = 0; n < 2; ++n) acc[a][b][m][n] = (f32x4){0.f, 0.f, 0.f, 0.f};
        cur = nxt; cA = nA; cB = nB; ++ui;
        if constexpr (ALIGN_EPI) { if (wr == 1) PG8_BAR; }
    }
    PG8_WAIT_V(0);
    if constexpr (!ALIGN_EPI) { if (wr == 0) PG8_BAR; }
    PG8_BAR;
    if constexpr (Epi::AFTER_DRAIN) { E.fused(acc, cur, wr, wc, fr, fq, lds, wid, lane); S.done(cur); }
#undef PG8_SA
#undef PG8_SB
#undef PG8_STAGE
#undef PG8_LDA
#undef PG8_LDB
#undef PG8_MMA
#undef PG8_WAIT_V
#undef PG8_WAIT_L
#undef PG8_BAR
#undef PG8_SCHED
}
}

#define GAS __attribute__((address_space(1)))
#define LAS __attribute__((address_space(3)))
typedef unsigned short bf16;
typedef unsigned v4u __attribute__((ext_vector_type(4)));
typedef float f32x4 __attribute__((ext_vector_type(4)));
typedef short bf16x8 __attribute__((ext_vector_type(8)));
typedef GAS unsigned gu32;
typedef GAS unsigned long long gu64;
#define RLX_AGENT __ATOMIC_RELAXED, __HIP_MEMORY_SCOPE_AGENT
#define LDS_WAIT() asm volatile("s_waitcnt lgkmcnt(0)" ::: "memory")
#define VM_WAIT() asm volatile("s_waitcnt vmcnt(0)" ::: "memory")
__device__ __forceinline__ unsigned long long rt() { return __builtin_amdgcn_s_memrealtime(); }
__device__ __forceinline__ unsigned f2bf(float f) { unsigned u = __builtin_bit_cast(unsigned, f); return (u + 0x7fffu + ((u >> 16) & 1u)) >> 16; }
__device__ __forceinline__ unsigned pk2(float lo, float hi) { return f2bf(lo) | (f2bf(hi) << 16); }

#define XB_TMO      128
#define XB_XCNT(j)  (256  + 64 * (j))
#define XB_XSUB(j)  (1280 + 64 * (j))
#define XB_XGEN(j)  (2304 + 64 * (j))
#define XB_TOP      3328
#define XB_TOPGEN   3392
#define XCD_BAR_WORDS 3456
#define XB_SPIN_CAP (1u << 18)

__device__ __forceinline__ unsigned xb_ld(unsigned* p)              { return __hip_atomic_load(p, __ATOMIC_RELAXED, __HIP_MEMORY_SCOPE_AGENT); }
__device__ __forceinline__ unsigned xb_add(unsigned* p, unsigned v) { return __hip_atomic_fetch_add(p, v, __ATOMIC_RELAXED, __HIP_MEMORY_SCOPE_AGENT); }
__device__ __forceinline__ unsigned xb_xcc_id() { return (unsigned)__builtin_amdgcn_s_getreg((3 << 11) | 20) & 0xFu; }
#define XB_SPIN(cond, bar) do { unsigned _sp = 0; while (cond) { __builtin_amdgcn_s_sleep(1); \
    if ((++_sp & 255u) == 0u) { if (xb_ld(&(bar)[XB_TMO])) break; if (_sp > XB_SPIN_CAP) { atomicAdd(&(bar)[XB_TMO], 1u); break; } } } } while (0)

struct XcdBarrier {
    unsigned* bar; unsigned x;
    volatile LAS unsigned* st;
};

__device__ __forceinline__ XcdBarrier xcd_barrier_post(unsigned* bar, volatile LAS unsigned* st) {
    XcdBarrier b; b.bar = bar; b.x = xb_xcc_id(); b.st = st;
    if (threadIdx.x == 0) (void)xb_add(&bar[XB_XCNT(b.x)], 1u);
    return b;
}
__device__ __forceinline__ void xcd_barrier_complete(unsigned* bar, unsigned x, unsigned& nloc, unsigned& nx) {
    const unsigned G = gridDim.x * gridDim.y * gridDim.z;
    unsigned sum, cnt, mine, sp = 0u;
    for (;;) {
        sum = 0u; cnt = 0u; mine = 0u;
#pragma unroll
        for (unsigned j = 0; j < 16; ++j) { const unsigned c = xb_ld(&bar[XB_XCNT(j)]); sum += c; cnt += (c > 0u) ? 1u : 0u; mine = (j == x) ? c : mine; }
        if (sum == G) break;
        __builtin_amdgcn_s_sleep(1);
        if ((++sp & 255u) == 0u) { if (xb_ld(&bar[XB_TMO])) break; if (sp > XB_SPIN_CAP) { atomicAdd(&bar[XB_TMO], 1u); break; } }
    }
    nloc = mine > 0u ? mine : 1u; nx = cnt > 0u ? cnt : 1u;
}

__device__ __forceinline__ void xcd_barrier(const XcdBarrier& b) {
    asm volatile("s_waitcnt vmcnt(0)" ::: "memory");
    __syncthreads();
    if (threadIdx.x == 0) {
        unsigned* bar = b.bar;
        __builtin_amdgcn_s_waitcnt(0);
        unsigned nloc = b.st[0], nx = b.st[1];
        if (nloc == 0u) { xcd_barrier_complete(bar, b.x, nloc, nx); b.st[0] = nloc; b.st[1] = nx; }
        const unsigned old = xb_add(&bar[XB_XSUB(b.x)], 1u);
        const unsigned gen = old / nloc;
        if (old + 1u == (gen + 1u) * nloc) {
            __builtin_amdgcn_fence(__ATOMIC_RELEASE, "agent");
            asm volatile("s_waitcnt vmcnt(0)" ::: "memory");
            const unsigned og = xb_add(&bar[XB_TOP], 1u);
            const unsigned tg = og / nx;
            if (og + 1u == (tg + 1u) * nx) xb_add(&bar[XB_TOPGEN], 1u);
            else XB_SPIN(xb_ld(&bar[XB_TOPGEN]) == tg, bar);
            __builtin_amdgcn_fence(__ATOMIC_ACQUIRE, "agent");
            xb_add(&bar[XB_XGEN(b.x)], 1u);
            asm volatile("s_waitcnt vmcnt(0)" ::: "memory");
        } else {
            XB_SPIN(xb_ld(&bar[XB_XGEN(b.x)]) == gen, bar);
            __builtin_amdgcn_fence(__ATOMIC_ACQUIRE, "agent");
            asm volatile("s_waitcnt vmcnt(0)" ::: "memory");
        }
    }
    __syncthreads();
}

constexpr int NWAVES = 8;
#ifndef MK_N_LAUNCHES
#define MK_N_LAUNCHES 1
#endif
constexpr int PER_PHASE = 8;
constexpr int N_LAUNCHES = MK_N_LAUNCHES;

constexpr int BATCH = 4, T = 4096, D = 1024, M = BATCH * T;
constexpr int NHEAD = 8, HD = 64, TOPK = 256;
constexpr int D_IN = 4680, NPROJ = 4864;
constexpr int C_CB = 0, C_CC = 512, C_CU = 1024, C_CZ = 1536, C_Q = 2048, C_K = 2560, C_V = 3072, C_AZ = 3584, C_IQ = 4096, C_IK = 4608, C_IW = 4672;
constexpr float EPS = 1e-6f;
constexpr float C2 = 0.125f * 1.4426950408889634f;
constexpr float IWSCALE = 0.35355339059327373f * 0.125f;

constexpr size_t MiB = 1u << 20;
constexpr size_t WS_CTL = 0, CTL_ZERO_BYTES = 1 * MiB;
constexpr size_t WS_ROPE = 1 * MiB;
constexpr size_t WS_IW = 2 * MiB;
constexpr size_t WS_WIN = 4 * MiB;
constexpr size_t WS_WOUT = 14 * MiB;
constexpr size_t WS_H = 16 * MiB;
constexpr size_t WS_PROJ = 48 * MiB;
constexpr size_t WS_MASK = 200 * MiB;
constexpr size_t WS_YCAT = 208 * MiB;
constexpr size_t WS_END = 240 * MiB;
constexpr int CW_TMO = 0, CW_CODE = 1, CW_BAR = 4096, CW_MOD = 131072;
static_assert((CW_MOD + BATCH * 3 * D) * 4 <= (int)CTL_ZERO_BYTES, "ctl map");

constexpr int RING_OFF = 0, RING_BYTES = 147456;
constexpr int LDSCTL_OFF = RING_BYTES, MISC_OFF = LDSCTL_OFF + 320;
constexpr int LDS_BYTES = RING_BYTES + 1024;

typedef unsigned short u16;
__device__ __forceinline__ float bf2f(u16 v) { return __uint_as_float((unsigned)v << 16); }
__device__ __forceinline__ float h2f(u16 v) { return (float)__builtin_bit_cast(_Float16, v); }
__device__ __forceinline__ u16 f2h(float f) { return __builtin_bit_cast(u16, (_Float16)f); }
__device__ __forceinline__ unsigned pk2h(float lo, float hi) { return (unsigned)f2h(lo) | ((unsigned)f2h(hi) << 16); }
__device__ __forceinline__ float siluf(float z) { return z / (1.f + __expf(-z)); }

struct Args { const void* in[13]; float* out; unsigned char* ws; float if0, if1, if2, if3, if4, if5, if6, if7; int ph_lo, ph_hi; };
struct Frame {
    LAS unsigned char* lds;
    volatile LAS unsigned* MISC;
    gu32* ctl;
    int tid, lane, wave, vcu, G;
    const float *x, *c, *w_ada, *b_ada, *norm_in, *w_in, *conv_w, *conv_b, *gn_conv, *gn_attn, *w_out, *norm_f; const int* positions;
    float* out; float* MOD; float* ROPE; float* IW;
    u16 *WIN, *WOUT, *H, *PROJ, *YCAT; unsigned* MASK;
};
__device__ __forceinline__ float wave_sum(float v) {
#pragma unroll
    for (int o = 1; o < 64; o <<= 1) v += __shfl_xor(v, o);
    return v;
}
__device__ __forceinline__ int wave_sum_i(int v) {
#pragma unroll
    for (int o = 1; o < 64; o <<= 1) v += __shfl_xor(v, o);
    return v;
}
__device__ __forceinline__ float wave_max(float v) {
#pragma unroll
    for (int o = 1; o < 64; o <<= 1) v = fmaxf(v, __shfl_xor(v, o));
    return v;
}
__device__ __forceinline__ void p0_transpose_item(const float* W, int K, int N, int Npad, u16* WT, LAS float* scr, int item, int lane) {
    const int nblk = Npad / 32, kb = item / nblk, nb = item % nblk, k0 = 64 * kb, n0 = 32 * nb;
    const int n_in = n0 + (lane & 31);
#pragma unroll 8
    for (int i = 0; i < 32; ++i) { const int kk = 2 * i + (lane >> 5); scr[kk * 33 + (lane & 31)] = (n_in < N) ? W[(size_t)(k0 + kk) * N + n_in] : 0.f; }
    LDS_WAIT(); asm volatile("" ::: "memory");
    const int c = lane & 7;
#pragma unroll
    for (int j = 0; j < 4; ++j) { const int n = (lane >> 3) + 8 * j; const LAS float* s = scr + (8 * c) * 33 + n;
        v4u o; o.x = pk2h(s[0 * 33], s[1 * 33]); o.y = pk2h(s[2 * 33], s[3 * 33]); o.z = pk2h(s[4 * 33], s[5 * 33]); o.w = pk2h(s[6 * 33], s[7 * 33]);
        *(GAS v4u*)(WT + (size_t)(n0 + n) * K + k0 + 8 * c) = o; }
    LDS_WAIT(); asm volatile("" ::: "memory");
}
__device__ __forceinline__ void sincos_acc(float ang, float& sn, float& cs) {
    double rev = (double)ang * 0.15915494309189535; rev -= floor(rev);
    const int q = (int)(rev * 4.0 + 0.5);
    const float th = (float)((rev - 0.25 * (double)q) * 6.283185307179586);
    const float t2 = th * th;
    const float s = th * (1.f + t2 * (-1.f / 6.f + t2 * (1.f / 120.f + t2 * (-1.f / 5040.f + t2 * (1.f / 362880.f)))));
    const float c = 1.f + t2 * (-0.5f + t2 * (1.f / 24.f + t2 * (-1.f / 720.f + t2 * (1.f / 40320.f))));
    switch (q & 3) { case 0: sn = s; cs = c; break; case 1: sn = c; cs = -s; break; case 2: sn = -s; cs = -c; break; default: sn = -c; cs = s; break; }
}

__device__ __forceinline__ void p0_prologue(Frame& F, const Args& A) {
    LAS float* scr = (LAS float*)(F.lds + RING_OFF + F.wave * 16384);
    const int gw = F.vcu * NWAVES + F.wave, NGW = F.G * NWAVES;
    constexpr int I_IN = (D / 64) * (NPROJ / 32), I_OUT = (D / 64) * (D / 32), I_MOD = 32 * 48;
    constexpr int NITEMS = I_IN + I_OUT + I_MOD;
    for (int it = gw; it < NITEMS; it += NGW) {
        int r = it;
        if (r < I_IN) { p0_transpose_item(F.w_in, D, D_IN, NPROJ, F.WIN, scr, r, F.lane); continue; } r -= I_IN;
        if (r < I_OUT) { p0_transpose_item(F.w_out, D, D, D, F.WOUT, scr, r, F.lane); continue; } r -= I_OUT;
        {
            const int kc = r / 48, cg = r % 48, col = cg * 64 + F.lane;
            float sv[BATCH];
#pragma unroll
            for (int b = 0; b < BATCH; ++b) sv[b] = siluf(F.c[b * D + kc * 32 + (F.lane & 31)]);
            float acc[BATCH];
#pragma unroll
            for (int b = 0; b < BATCH; ++b) acc[b] = (kc == 0) ? F.b_ada[col] : 0.f;
#pragma unroll 8
            for (int kk = 0; kk < 32; ++kk) { const float wv = F.w_ada[(size_t)(kc * 32 + kk) * (3 * D) + col];
#pragma unroll
                for (int b = 0; b < BATCH; ++b) acc[b] += __shfl(sv[b], kk) * wv; }
#pragma unroll
            for (int b = 0; b < BATCH; ++b) atomicAdd(F.MOD + b * 3 * D + col, acc[b]);
        }
    }
    const int ri = F.lane & 7;
    const float ifr = ri == 0 ? A.if0 : ri == 1 ? A.if1 : ri == 2 ? A.if2 : ri == 3 ? A.if3 : ri == 4 ? A.if4 : ri == 5 ? A.if5 : ri == 6 ? A.if6 : A.if7;
    for (int e = (gw * 64 + F.lane); e < M * 8; e += NGW * 64) { const int m = e >> 3, i = e & 7;
        const float ang = (float)F.positions[m] * ifr; float sn, cs; sincos_acc(ang, sn, cs);
        F.ROPE[m * 16 + i] = cs; F.ROPE[m * 16 + 8 + i] = sn; }
}
__device__ __forceinline__ void p1_rows(Frame& F) {
    const int gw = F.vcu * NWAVES + F.wave, NGW = F.G * NWAVES;
    for (int m = gw; m < M; m += NGW) {
        const int b = m / T;
        const GAS f32x4* xr = (const GAS f32x4*)(F.x + (size_t)m * D) + F.lane;
        f32x4 v[4]; float s = 0.f;
#pragma unroll
        for (int j = 0; j < 4; ++j) { v[j] = xr[64 * j]; s += (v[j].x * v[j].x + v[j].y * v[j].y) + (v[j].z * v[j].z + v[j].w * v[j].w); }
        const float inv = 1.f / sqrtf(wave_sum(s) * (1.f / D) + EPS);
        GAS unsigned long long* o8 = (GAS unsigned long long*)(F.H + (size_t)m * D) + F.lane;
#pragma unroll
        for (int j = 0; j < 4; ++j) { const int col = 4 * F.lane + 256 * j;
            const f32x4 g = *(const f32x4*)(F.norm_in + col), sh = *(const f32x4*)(F.MOD + b * 3 * D + col), sc = *(const f32x4*)(F.MOD + b * 3 * D + D + col);
            const f32x4 h = (v[j] * inv) * g * (sc + 1.f) + sh;
            o8[64 * j] = (unsigned long long)pk2h(h.x, h.y) | ((unsigned long long)pk2h(h.z, h.w) << 32); }
    }
}
__device__ __forceinline__ void p3_rows(Frame& F) {
    const int gw = F.vcu * NWAVES + F.wave, NGW = F.G * NWAVES, lane = F.lane;
    for (int m = gw; m < M; m += NGW) {
        const int t = m % T;
        u16* prow = F.PROJ + (size_t)m * NPROJ;
        const int h = lane >> 3, i = lane & 7;
        const float cs = F.ROPE[m * 16 + i], sn = F.ROPE[m * 16 + 8 + i];
        { u16* p = prow + C_Q + h * 64; const float x1 = bf2f(p[i]), x2 = bf2f(p[8 + i]); p[i] = (u16)f2bf(x1 * cs - x2 * sn); p[8 + i] = (u16)f2bf(x1 * sn + x2 * cs); }
        { u16* p = prow + C_K + h * 64; const float x1 = bf2f(p[i]), x2 = bf2f(p[8 + i]); p[i] = (u16)f2bf(x1 * cs - x2 * sn); p[8 + i] = (u16)f2bf(x1 * sn + x2 * cs); }
        { u16* p = prow + C_IQ + h * 64; const float x1 = h2f(p[i]), x2 = h2f(p[8 + i]); p[i] = f2h(x1 * cs - x2 * sn); p[8 + i] = f2h(x1 * sn + x2 * cs); }
        if (h == 0) { u16* p = prow + C_IK; const float x1 = h2f(p[i]), x2 = h2f(p[8 + i]); p[i] = f2h(x1 * cs - x2 * sn); p[8 + i] = f2h(x1 * sn + x2 * cs); }
        const int c0 = lane * 8;
        const v4u z4 = {0u, 0u, 0u, 0u};
        const v4u cbv = *(const v4u*)(prow + C_CB + c0), czv = *(const v4u*)(prow + C_CZ + c0);
        const v4u cc0 = *(const v4u*)(prow + C_CC + c0), cu0 = *(const v4u*)(prow + C_CU + c0);
        const v4u cc1 = t >= 1 ? *(const v4u*)(prow - NPROJ + C_CC + c0) : z4, cu1 = t >= 1 ? *(const v4u*)(prow - NPROJ + C_CU + c0) : z4;
        const v4u cc2 = t >= 2 ? *(const v4u*)(prow - 2 * NPROJ + C_CC + c0) : z4, cu2 = t >= 2 ? *(const v4u*)(prow - 2 * NPROJ + C_CU + c0) : z4;
        float y[8]; float ss = 0.f;
#pragma unroll
        for (int e = 0; e < 8; ++e) {
            const int wd = e >> 1; const bool hi = e & 1;
#define UNP(v) (hi ? __uint_as_float((v)[wd] & 0xffff0000u) : __uint_as_float((v)[wd] << 16))
            const float s0 = UNP(cc0) * UNP(cu0), s1 = UNP(cc1) * UNP(cu1), s2 = UNP(cc2) * UNP(cu2);
            const int c = c0 + e;
            const float cv = F.conv_b[c] + F.conv_w[c] * s2 + F.conv_w[512 + c] * s1 + F.conv_w[1024 + c] * s0;
            y[e] = UNP(cbv) * cv; ss += y[e] * y[e];
        }
        ss += __shfl_xor(ss, 1); ss += __shfl_xor(ss, 2); ss += __shfl_xor(ss, 4);
        const float inv = 1.f / sqrtf(ss * (1.f / 64.f) + EPS);
        float o[8];
#pragma unroll
        for (int e = 0; e < 8; ++e) { const int wd = e >> 1; const bool hi = e & 1; o[e] = y[e] * inv * F.gn_conv[c0 + e] * siluf(UNP(czv)); }
#undef UNP
        v4u ov; ov.x = pk2h(o[0], o[1]); ov.y = pk2h(o[2], o[3]); ov.z = pk2h(o[4], o[5]); ov.w = pk2h(o[6], o[7]);
        *(v4u*)(F.YCAT + (size_t)m * D + c0) = ov;
    }
}
__device__ __forceinline__ unsigned okey(float s) { const unsigned u = __float_as_uint(s); return (u & 0x80000000u) ? ~u : (u | 0x80000000u); }
__device__ __forceinline__ void p4_indexer(Frame& F) {
    const int gw = F.vcu * NWAVES + F.wave, NGW = F.G * NWAVES, lane = F.lane;
    LAS float* iqf = (LAS float*)(F.lds + RING_OFF + F.wave * 18432);
    LAS float* sc = iqf + 512;
    for (int m = gw; m < M; m += NGW) {
        const int b = m / T, t = m % T, n = t + 1;
        unsigned* mrow = F.MASK + (size_t)m * 128;
        if (n <= TOPK) {
            for (int w = lane; w < 128; w += 64) { const int k0 = 32 * w; mrow[w] = (k0 + 31 <= t) ? 0xffffffffu : (k0 > t ? 0u : ((1u << (t - k0 + 1)) - 1u)); }
            continue;
        }
        const u16* prow = F.PROJ + (size_t)m * NPROJ;
        for (int e = lane; e < 512; e += 64) iqf[e] = h2f(prow[C_IQ + e]);
        const float wv = (lane < 8) ? F.IW[m * 8 + lane] : 0.f;
        float wh[8];
#pragma unroll
        for (int h = 0; h < 8; ++h) wh[h] = __shfl(wv, h);
        LDS_WAIT(); asm volatile("" ::: "memory");
        for (int s = lane; s < n; s += 64) {
            const v4u* kr = (const v4u*)(F.PROJ + (size_t)(b * T + s) * NPROJ + C_IK);
            float kf[64];
#pragma unroll
            for (int q = 0; q < 8; ++q) { const v4u v = kr[q];
#pragma unroll
                for (int e = 0; e < 4; ++e) { const unsigned w = v[e]; kf[q * 8 + 2 * e] = h2f((u16)(w & 0xffffu)); kf[q * 8 + 2 * e + 1] = h2f((u16)(w >> 16)); } }
            float score = 0.f;
#pragma unroll
            for (int h = 0; h < 8; ++h) { float d = 0.f;
#pragma unroll
                for (int dd = 0; dd < 64; ++dd) d = fmaf(iqf[h * 64 + dd], kf[dd], d);
                score = fmaf(wh[h], fmaxf(d, 0.f), score); }
            sc[s] = score;
        }
        LDS_WAIT(); asm volatile("" ::: "memory");
        unsigned keys[64];
#pragma unroll
        for (int j = 0; j < 64; ++j) { const int s = j * 64 + lane; keys[j] = (s < n) ? okey(sc[s]) : 0u; }
        unsigned Tk = 0u;
        for (int bit = 31; bit >= 0; --bit) { const unsigned cand = Tk | (1u << bit); int c = 0;
#pragma unroll
            for (int j = 0; j < 64; ++j) c += (keys[j] >= cand) ? 1 : 0;
            c = wave_sum_i(c); if (c >= TOPK) Tk = cand; }
        int cgt = 0;
#pragma unroll
        for (int j = 0; j < 64; ++j) cgt += (keys[j] > Tk) ? 1 : 0;
        cgt = wave_sum_i(cgt);
        const int need = TOPK - cgt; int base = 0;
        const unsigned long long ltm = (1ull << lane) - 1ull;
#pragma unroll
        for (int j = 0; j < 64; ++j) {
            const bool tie = keys[j] == Tk; const unsigned long long bl = __ballot(tie);
            const int rank = base + __popcll(bl & ltm);
            const bool sel = (keys[j] > Tk) || (tie && rank < need); base += __popcll(bl);
            const unsigned long long sb = __ballot(sel);
            if (lane == 0) { mrow[2 * j] = (unsigned)sb; mrow[2 * j + 1] = (unsigned)(sb >> 32); }
        }
        LDS_WAIT(); asm volatile("" ::: "memory");
    }
}
__device__ __forceinline__ void p5_attn(Frame& F) {
    const int gw = F.vcu * NWAVES + F.wave, NGW = F.G * NWAVES, lane = F.lane;
    LAS int* idx = (LAS int*)(F.lds + RING_OFF + F.wave * 4096);
    LAS float* qf = (LAS float*)(idx + 256);
    LAS float* pl = qf + 64;
    const unsigned long long ltm = (1ull << lane) - 1ull;
    for (int m = gw; m < M; m += NGW) {
        const int b = m / T, t = m % T;
        const unsigned* mrow = F.MASK + (size_t)m * 128;
        int base = 0;
        for (int j = 0; j <= (t >> 6); ++j) {
            const unsigned long long bm = (unsigned long long)mrow[2 * j] | ((unsigned long long)mrow[2 * j + 1] << 32);
            const bool sel = (bm >> lane) & 1ull; const int pos = base + __popcll(bm & ltm);
            if (sel && pos < TOPK) idx[pos] = j * 64 + lane;
            base += __popcll(bm);
        }
        const int nsel = base < TOPK ? base : TOPK;
        const u16* prow = F.PROJ + (size_t)m * NPROJ;
        for (int h = 0; h < NHEAD; ++h) {
            qf[lane] = bf2f(prow[C_Q + h * 64 + lane]);
            LDS_WAIT(); asm volatile("" ::: "memory");
            float lg[4]; float mx = -INFINITY;
#pragma unroll
            for (int c = 0; c < 4; ++c) { const int p = c * 64 + lane; lg[c] = -INFINITY;
                if (p < nsel) { const int s = idx[p]; const v4u* kr = (const v4u*)(F.PROJ + (size_t)(b * T + s) * NPROJ + C_K + h * 64); float d = 0.f;
#pragma unroll
                    for (int q = 0; q < 8; ++q) { const v4u v = kr[q];
#pragma unroll
                        for (int e = 0; e < 4; ++e) { d = fmaf(qf[q * 8 + 2 * e], __uint_as_float(v[e] << 16), d); d = fmaf(qf[q * 8 + 2 * e + 1], __uint_as_float(v[e] & 0xffff0000u), d); } }
                    lg[c] = d; }
                mx = fmaxf(mx, lg[c]); }
            mx = wave_max(mx);
            float sum = 0.f;
#pragma unroll
            for (int c = 0; c < 4; ++c) { const int p = c * 64 + lane; const float pe = (p < nsel) ? exp2f(lg[c] - mx) : 0.f; sum += pe; pl[p] = pe; }
            sum = wave_sum(sum);
            LDS_WAIT(); asm volatile("" ::: "memory");
            float acc = 0.f;
            const u16* vb = F.PROJ + (size_t)(b * T) * NPROJ + C_V + h * 64 + lane;
#pragma unroll 4
            for (int p = 0; p < nsel; ++p) acc = fmaf(pl[p], bf2f(vb[(size_t)idx[p] * NPROJ]), acc);
            const float o = acc / sum;
            const float ssq = wave_sum(o * o);
            const float y = o * (1.f / sqrtf(ssq * (1.f / 64.f) + EPS)) * F.gn_attn[h * 64 + lane] * siluf(bf2f(prow[C_AZ + h * 64 + lane]));
            F.YCAT[(size_t)m * D + 512 + h * 64 + lane] = f2h(y);
            LDS_WAIT(); asm volatile("" ::: "memory");
        }
    }
}
__device__ __forceinline__ void p7_rows(Frame& F) {
    const int gw = F.vcu * NWAVES + F.wave, NGW = F.G * NWAVES;
    for (int m = gw; m < M; m += NGW) {
        GAS f32x4* xr = (GAS f32x4*)(F.out + (size_t)m * D) + F.lane;
        f32x4 v[4]; float s = 0.f;
#pragma unroll
        for (int j = 0; j < 4; ++j) { v[j] = xr[64 * j]; s += (v[j].x * v[j].x + v[j].y * v[j].y) + (v[j].z * v[j].z + v[j].w * v[j].w); }
        const float inv = 1.f / sqrtf(wave_sum(s) * (1.f / D) + EPS);
#pragma unroll
        for (int j = 0; j < 4; ++j) { const f32x4 g = *(const f32x4*)(F.norm_f + 4 * F.lane + 256 * j); xr[64 * j] = (v[j] * inv) * g; }
    }
}

__global__ void __launch_bounds__(NWAVES * 64, 2) fwd_kernel(Args args) {
    extern __shared__ __attribute__((aligned(16))) unsigned char lds[];
    Frame F;
    F.lds = (LAS unsigned char*)lds;
    F.MISC = (volatile LAS unsigned*)(F.lds + MISC_OFF);
    F.tid = threadIdx.x; F.lane = F.tid & 63; F.wave = __builtin_amdgcn_readfirstlane(F.tid >> 6);
    F.G = gridDim.x; { const int bx = blockIdx.x; F.vcu = (F.G % 8 == 0) ? (bx % 8) * (F.G / 8) + bx / 8 : bx; }
    unsigned char* ws = args.ws;
    F.ctl = (gu32*)(ws + WS_CTL);
    F.x = (const float*)args.in[0]; F.c = (const float*)args.in[1]; F.positions = (const int*)args.in[2]; F.w_ada = (const float*)args.in[3]; F.b_ada = (const float*)args.in[4];
    F.norm_in = (const float*)args.in[5]; F.w_in = (const float*)args.in[6]; F.conv_w = (const float*)args.in[7]; F.conv_b = (const float*)args.in[8];
    F.gn_conv = (const float*)args.in[9]; F.gn_attn = (const float*)args.in[10]; F.w_out = (const float*)args.in[11]; F.norm_f = (const float*)args.in[12];
    F.out = args.out;
    F.MOD = (float*)(ws + WS_CTL) + CW_MOD; F.ROPE = (float*)(ws + WS_ROPE); F.IW = (float*)(ws + WS_IW);
    F.WIN = (u16*)(ws + WS_WIN); F.WOUT = (u16*)(ws + WS_WOUT); F.H = (u16*)(ws + WS_H); F.PROJ = (u16*)(ws + WS_PROJ); F.YCAT = (u16*)(ws + WS_YCAT); F.MASK = (unsigned*)(ws + WS_MASK);
    for (int u = F.tid; u < (LDS_BYTES - LDSCTL_OFF) / 4; u += NWAVES * 64) ((LAS unsigned*)(F.lds + LDSCTL_OFF))[u] = 0u;
    __syncthreads();
    XcdBarrier bar; bar.bar = (unsigned*)(F.ctl + CW_BAR); bar.x = 0; bar.st = nullptr;
    if (N_LAUNCHES != PER_PHASE) bar = xcd_barrier_post((unsigned*)(F.ctl + CW_BAR), F.MISC + 8);
#define GRID_BAR(seam) do { if (N_LAUNCHES == PER_PHASE) { if (F.tid == 0) __hip_atomic_store(F.ctl + CW_TMO, 0xBADBA0u | (unsigned)(seam), RLX_AGENT); } else { xcd_barrier(bar); } } while (0)
    const int lo = args.ph_lo, hi = args.ph_hi;
#define IN(k) (lo <= (k) && (k) < hi)
#define BOTH(k) (IN(k) && IN((k) + 1))
    if (IN(0)) { p0_prologue(F, args); if (BOTH(0)) GRID_BAR(0); }
    if (IN(1)) { p1_rows(F); if (BOTH(1)) GRID_BAR(1); }
    if (IN(2)) {
        pg8::Gemm g{F.H, F.WIN, M, NPROJ, D}; pg8::StaticOrder S; S.init(M, NPROJ, F.G, (int)blockIdx.x);
        pg8::EpiProj E{F.PROJ, NPROJ, F.IW, C2, IWSCALE};
        pg8::gemm_phase<pg8::EpiProj, pg8::StaticOrder, true, true, true>(F.lds + RING_OFF, g, S, E);
        if (BOTH(2)) GRID_BAR(2);
    }
    if (IN(3)) { p3_rows(F); if (BOTH(3)) GRID_BAR(3); }
    if (IN(4)) { p4_indexer(F); if (BOTH(4)) GRID_BAR(4); }
    if (IN(5)) { p5_attn(F); if (BOTH(5)) GRID_BAR(5); }
    if (IN(6)) {
        pg8::Gemm g{F.YCAT, F.WOUT, M, D, D}; pg8::StaticOrder S; S.init(M, D, F.G, (int)blockIdx.x);
        pg8::EpiOut E{F.x, F.out, D, F.MOD + 2 * D, 3 * D, T};
        pg8::gemm_phase<pg8::EpiOut, pg8::StaticOrder, false, true, true>(F.lds + RING_OFF, g, S, E);
        if (BOTH(6)) GRID_BAR(6);
    }
    if (IN(7)) { p7_rows(F); }
#undef IN
#undef BOTH
}

extern "C" void kernel_launch(void* const* d_in, const int* in_sizes, int n_in, void* d_out, int out_size, void* d_ws, size_t ws_size, hipStream_t stream) {
    static int grid = 0;
    if (grid == 0) {
        if (n_in != 13 || in_sizes[0] != M * D || out_size != M * D || ws_size < WS_END) { fprintf(stderr, "kernel_launch: unexpected shapes (n_in %d, in0 %d, out %d, ws %zu); nothing launched\n", n_in, n_in > 0 ? in_sizes[0] : -1, out_size, ws_size); grid = -1; return; }
        int dev = 0, cus = 0, per_cu = 0;
        if (hipGetDevice(&dev) != hipSuccess || hipDeviceGetAttribute(&cus, hipDeviceAttributeMultiprocessorCount, dev) != hipSuccess) { grid = -1; return; }
        if (hipFuncSetAttribute((const void*)fwd_kernel, hipFuncAttributeMaxDynamicSharedMemorySize, LDS_BYTES) != hipSuccess) { fprintf(stderr, "kernel_launch: hipFuncSetAttribute failed\n"); grid = -1; return; }
        if (hipOccupancyMaxActiveBlocksPerMultiprocessor(&per_cu, (const void*)fwd_kernel, NWAVES * 64, LDS_BYTES) != hipSuccess || per_cu < 1)
            fprintf(stderr, "kernel_launch: note: occupancy query reports %d workgroups per CU\n", per_cu);
        (void)hipGetLastError();
        grid = cus;
    }
    if (grid < 0) return;
    if (hipMemsetAsync((char*)d_ws + WS_CTL, 0, CTL_ZERO_BYTES, stream) != hipSuccess) return;
    Args a{};
    for (int i = 0; i < 13; ++i) a.in[i] = d_in[i];
    a.out = (float*)d_out; a.ws = (unsigned char*)d_ws;
    { float f[8]; for (int i = 0; i < 8; ++i) f[i] = (float)pow(500000.0, -(double)i / 8.0); a.if0 = f[0]; a.if1 = f[1]; a.if2 = f[2]; a.if3 = f[3]; a.if4 = f[4]; a.if5 = f[5]; a.if6 = f[6]; a.if7 = f[7]; }
    for (int li = 0; li < N_LAUNCHES; ++li) {
        a.ph_lo = (N_LAUNCHES == PER_PHASE) ? li : 0; a.ph_hi = (N_LAUNCHES == PER_PHASE) ? li + 1 : PER_PHASE;
        hipLaunchKernelGGL(fwd_kernel, dim3(grid), dim3(NWAVES * 64), LDS_BYTES, stream, a);
        const hipError_t le = hipPeekAtLastError();
        if (le != hipSuccess) { fprintf(stderr, "kernel_launch: launch %d failed: %s\n", li, hipGetErrorName(le)); break; }
    }
}
```

```cpp
#include <hip/hip_runtime.h>
#include <cstdio>
#include <cstdint>
#include <cmath>
namespace pg8 {
#define PG8_LAS __attribute__((address_space(3)))
typedef unsigned short bf16_t;
typedef short bf16x8 __attribute__((ext_vector_type(8)));
typedef float f32x4 __attribute__((ext_vector_type(4)));
typedef unsigned u32x4 __attribute__((ext_vector_type(4)));
constexpr int BM = 256, BK = 64, HALF = 128, HTB = HALF * BK * 2  , STAGE_BYTES = 8 * HTB, NXCD = 8, WGM = 8;

__host__ __device__ __forceinline__ int lds_byte(int r, int c) { const int st = (r >> 4) * 2 + (c >> 5), rr = r & 15, cc = c & 31, ob = rr * 64 + cc * 2; return st * 1024 + (ob ^ (((ob >> 9) & 1) << 5)); }
__host__ __device__ __forceinline__ void stage_rc(int b, int& R, int& C) { const int st = b / 1024, sb = b % 1024, swz = sb ^ (((sb >> 9) & 1) << 5); R = (st >> 1) * 16 + swz / 64; C = (st & 1) * 32 + (swz % 64) / 2; }
__host__ __device__ __forceinline__ int perm32(int rho) { const int n = rho >> 4, i = rho & 15; return 8 * (i >> 2) + 4 * n + (i & 3); }

struct Unit { int pm, pn; };
struct Gemm { const bf16_t* A; const bf16_t* Bt; int M, N, K; };

struct StaticOrder {
    int nM, nN, nwg, G, c;
    __host__ __device__ void init(int M, int N, int G_, int c_) { nM = M / BM; nN = N / BM; nwg = nM * nN; G = G_; c = c_; }
    __host__ __device__ bool next(int i, Unit& u) const {
        const long L = (long)i * G + c; if (L >= nwg) return false;
        int wgid = (int)L; { const int q = nwg / NXCD, r = nwg % NXCD, xcd = wgid % NXCD, off = wgid / NXCD; wgid = (xcd < r ? xcd * (q + 1) : r * (q + 1) + (xcd - r) * q) + off; }
        const int nig = WGM * nN, gid = wgid / nig, fm = gid * WGM, gsz = (nM - fm) < WGM ? (nM - fm) : WGM;
        u.pm = fm + ((wgid % nig) % gsz); u.pn = (wgid % nig) / gsz; return true;
    }
    __device__ __forceinline__ void a_ready(const Unit&) const {}
    __device__ __forceinline__ void done(const Unit&) const {}
};

__device__ __forceinline__ unsigned cvt_pk_bf16(float lo, float hi) { unsigned r; asm volatile("v_cvt_pk_bf16_f32 %0, %1, %2" : "=v"(r) : "v"(lo), "v"(hi)); return r; }
typedef float f32x2 __attribute__((ext_vector_type(2)));
typedef _Float16 f16x8 __attribute__((ext_vector_type(8)));
typedef _Float16 f16x2 __attribute__((ext_vector_type(2)));
__device__ __forceinline__ unsigned cvt_pk_f16(float lo, float hi) { f16x2 v = {(_Float16)lo, (_Float16)hi}; return __builtin_bit_cast(unsigned, v); }
template <bool F16> __device__ __forceinline__ f32x4 mma16(bf16x8 a, bf16x8 b, f32x4 c) {
    if constexpr (F16) return __builtin_amdgcn_mfma_f32_16x16x32_f16(__builtin_bit_cast(f16x8, a), __builtin_bit_cast(f16x8, b), c, 0, 0, 0);
    else return __builtin_amdgcn_mfma_f32_16x16x32_bf16(a, b, c, 0, 0, 0);
}

struct EpiProj {
    static constexpr bool PERM = true, AFTER_DRAIN = false;
    bf16_t* CONV; size_t gstride; float* IW; float qscale, iwscale;
    __device__ __forceinline__ void operator()(const f32x4 (&acc)[2][2][4][2], const Unit& u, int wr, int wc, int fr, int fq) const {
        const int grp = u.pn >> 3; bf16_t* O = CONV + (size_t)grp * gstride; const int ldc = grp == 2 ? 768 : 2048;
        const int row0 = u.pm * BM + wr * 64 + fr; const int col0 = (u.pn & 7) * BM + wc * 32 + 8 * fq;
        const float sc = (u.pn == 8 || u.pn == 9) ? qscale : 1.f; const bool h16 = u.pn >= 16;
#pragma unroll
        for (int ai = 0; ai < 2; ++ai)
#pragma unroll
            for (int m = 0; m < 4; ++m) { const int row = row0 + ai * HALF + m * 16; bf16_t* rowp = O + (size_t)row * ldc + col0;
#pragma unroll
                for (int bj = 0; bj < 2; ++bj) { const f32x4 v0 = acc[ai][bj][m][0] * sc, v1 = acc[ai][bj][m][1] * sc; u32x4 w;
                    if (h16) { w.x = cvt_pk_f16(v0[0], v0[1]); w.y = cvt_pk_f16(v0[2], v0[3]); w.z = cvt_pk_f16(v1[0], v1[1]); w.w = cvt_pk_f16(v1[2], v1[3]); }
                    else { w.x = cvt_pk_bf16(v0[0], v0[1]); w.y = cvt_pk_bf16(v0[2], v0[3]); w.z = cvt_pk_bf16(v1[0], v1[1]); w.w = cvt_pk_bf16(v1[2], v1[3]); }
                    *(u32x4*)(rowp + bj * HALF) = w;
                    if (bj == 0 && u.pn == 18 && wc == 2 && fq == 0) { float* ip = IW + (size_t)row * 8; *(f32x4*)ip = v0 * iwscale; *(f32x4*)(ip + 4) = v1 * iwscale; } } }
    }
};
struct EpiOut {
    static constexpr bool PERM = false, AFTER_DRAIN = false;
    const float* x; float* out; int ldc; const float* gate; int gstride; int rows_per_batch;
    __device__ __forceinline__ void operator()(const f32x4 (&acc)[2][2][4][2], const Unit& u, int wr, int wc, int fr, int fq) const {
        const int row0 = u.pm * BM + wr * 64 + fr; const int col0 = u.pn * BM + wc * 32 + 4 * fq;
        const float* g = gate + (size_t)((u.pm * BM) / rows_per_batch) * gstride;
        f32x4 gv[2][2];
#pragma unroll
        for (int bj = 0; bj < 2; ++bj)
#pragma unroll
            for (int n = 0; n < 2; ++n) gv[bj][n] = *(const f32x4*)(g + col0 + bj * HALF + n * 16);
#pragma unroll
        for (int ai = 0; ai < 2; ++ai)
#pragma unroll
            for (int m = 0; m < 4; ++m) { const size_t off = (size_t)(row0 + ai * HALF + m * 16) * ldc + col0;
#pragma unroll
                for (int bj = 0; bj < 2; ++bj)
#pragma unroll
                    for (int n = 0; n < 2; ++n) { const f32x4 xv = *(const f32x4*)(x + off + bj * HALF + n * 16);
                        *(f32x4*)(out + off + bj * HALF + n * 16) = xv + gv[bj][n] * acc[ai][bj][m][n]; } }
    }
};

template <class Epi, class Sched, bool ALIGN_EPI = false, bool SP2 = false, bool F16 = false>
__device__ __forceinline__ void gemm_phase(PG8_LAS unsigned char* lds, const Gemm g, const Sched& S, const Epi& E) {
    const int tid = threadIdx.x, wid = __builtin_amdgcn_readfirstlane(tid >> 6), lane = tid & 63, wr = wid >> 2, wc = wid & 3, fr = lane & 15, fq = lane >> 4;
    const int K = g.K, nt = K / BK;
    unsigned voffA[2], voffB[2];
#pragma unroll
    for (int i = 0; i < 2; ++i) { int R, C; stage_rc(tid * 16 + i * 8192, R, C); const int Rb = Epi::PERM ? ((R & ~31) + perm32(R & 31)) : R;
        voffA[i] = (unsigned)(R * K + C) * 2u; voffB[i] = (unsigned)(Rb * K + C) * 2u; }
    const size_t kstep = (size_t)(BK * 2);
    const size_t hstep = (size_t)HALF * K * 2;
    const size_t tstep = 2 * hstep;
    const unsigned ldsw = (unsigned)wid * 1024u;
    const int aoff = lds_byte(wr * 64 + fr, fq * 8), boff = lds_byte(wc * 32 + fr, fq * 8);
#define PG8_SA(b, h) (((b) * 2 + (h)) * HTB)
#define PG8_SB(b, h) ((4 + (b) * 2 + (h)) * HTB)
#define PG8_STAGE(bufoff, gbase, voff) do { _Pragma("unroll") for (int _i = 0; _i < 2; ++_i) \
        __builtin_amdgcn_global_load_lds((const unsigned*)((const char*)(gbase) + (voff)[_i]), (PG8_LAS unsigned*)(lds + (bufoff) + ldsw + _i * 8192), 16, 0, 0); } while (0)
#define PG8_LDA(dst, b, h) do { _Pragma("unroll") for (int m = 0; m < 4; ++m) _Pragma("unroll") for (int k = 0; k < 2; ++k) dst[m][k] = *(const PG8_LAS bf16x8*)(lds + PG8_SA(b, h) + aoff + m * 2048 + k * 1024); } while (0)
#define PG8_LDB(dst, b, h) do { _Pragma("unroll") for (int n = 0; n < 2; ++n) _Pragma("unroll") for (int k = 0; k < 2; ++k) dst[n][k] = *(const PG8_LAS bf16x8*)(lds + PG8_SB(b, h) + boff + n * 2048 + k * 1024); } while (0)
#define PG8_MMA(ai, bj, At, Bt) do { __builtin_amdgcn_s_setprio(1); _Pragma("unroll") for (int m = 0; m < 4; ++m) _Pragma("unroll") for (int n = 0; n < 2; ++n) _Pragma("unroll") for (int k = 0; k < 2; ++k) \
        acc[ai][bj][m][n] = mma16<F16>(Bt[n][k], At[m][k], acc[ai][bj][m][n]); __builtin_amdgcn_s_setprio(0); } while (0)
#define PG8_WAIT_V(n) asm volatile("s_waitcnt vmcnt(" #n ")" ::: "memory")
#define PG8_WAIT_L(n) asm volatile("s_waitcnt lgkmcnt(" #n ")" ::: "memory")
#define PG8_BAR __builtin_amdgcn_s_barrier()
#define PG8_SCHED __builtin_amdgcn_sched_barrier(0)
    Unit cur, nxt; int ui = 0;
    if (!S.next(0, cur)) return;
    f32x4 acc[2][2][4][2];
#pragma unroll
    for (int a = 0; a < 2; ++a)
#pragma unroll
        for (int b = 0; b < 2; ++b)
#pragma unroll
            for (int m = 0; m < 4; ++m)
#pragma unroll
                for (int n = 0; n < 2; ++n) acc[a][b][m][n] = (f32x4){0.f, 0.f, 0.f, 0.f};
    bf16x8 At[4][2], B0[2][2], B1[2][2];
    const char* cA = (const char*)g.A + (size_t)cur.pm * tstep; const char* cB = (const char*)g.Bt + (size_t)cur.pn * tstep;
    S.a_ready(cur);
    if constexpr (SP2) {
        PG8_STAGE(PG8_SB(0, 0), cB, voffB); PG8_STAGE(PG8_SB(0, 1), cB + hstep, voffB); PG8_STAGE(PG8_SA(0, 0), cA, voffA); PG8_STAGE(PG8_SA(0, 1), cA + hstep, voffA);
        if (wr == 1) PG8_BAR;
        PG8_WAIT_V(2); PG8_BAR;
        PG8_STAGE(PG8_SB(1, 0), cB + kstep, voffB); PG8_STAGE(PG8_SA(1, 0), cA + kstep, voffA); PG8_STAGE(PG8_SB(1, 1), cB + hstep + kstep, voffB);
        PG8_WAIT_V(6); PG8_BAR;
    } else {
        PG8_STAGE(PG8_SB(0, 0), cB, voffB); PG8_STAGE(PG8_SA(0, 0), cA, voffA); PG8_STAGE(PG8_SB(0, 1), cB + hstep, voffB); PG8_STAGE(PG8_SA(0, 1), cA + hstep, voffA);
        if (wr == 1) PG8_BAR;
        PG8_WAIT_V(4); PG8_BAR;
        PG8_STAGE(PG8_SB(1, 0), cB + kstep, voffB); PG8_STAGE(PG8_SA(1, 0), cA + kstep, voffA); PG8_STAGE(PG8_SB(1, 1), cB + hstep + kstep, voffB);
        PG8_WAIT_V(6); PG8_BAR;
    }
    for (;;) {
        const bool has_next = S.next(ui + 1, nxt);
        const char* nA = has_next ? (const char*)g.A + (size_t)nxt.pm * tstep : cA; const char* nB = has_next ? (const char*)g.Bt + (size_t)nxt.pn * tstep : cB;
        for (int t = 0; t < nt; t += 2) {
            const bool last = (t == nt - 2);
            const char* a1 = cA + (size_t)(t + 1) * kstep;
            const char* a2 = last ? nA : cA + (size_t)(t + 2) * kstep; const char* b2 = last ? nB : cB + (size_t)(t + 2) * kstep;
            const char* a3 = a2 + kstep; const char* b3 = b2 + kstep;
            if (last && has_next) S.a_ready(nxt);
            if constexpr (SP2) {
            PG8_LDB(B0, 0, 0); PG8_LDB(B1, 0, 1); PG8_SCHED; PG8_LDA(At, 0, 0); PG8_STAGE(PG8_SA(1, 1), a1 + hstep, voffA);
            PG8_WAIT_V(8); PG8_WAIT_L(0); PG8_BAR; PG8_MMA(0, 0, At, B0); PG8_MMA(0, 1, At, B1); PG8_BAR; PG8_SCHED;
            PG8_LDA(At, 0, 1); PG8_STAGE(PG8_SB(0, 0), b2, voffB); PG8_STAGE(PG8_SB(0, 1), b2 + hstep, voffB); PG8_STAGE(PG8_SA(0, 0), a2, voffA);
            PG8_WAIT_V(8); PG8_WAIT_L(0); PG8_BAR; PG8_MMA(1, 0, At, B0); PG8_MMA(1, 1, At, B1); PG8_BAR; PG8_SCHED;
            PG8_LDB(B0, 1, 0); PG8_LDB(B1, 1, 1); PG8_SCHED; PG8_LDA(At, 1, 0); PG8_STAGE(PG8_SA(0, 1), a2 + hstep, voffA);
            PG8_WAIT_V(8); PG8_WAIT_L(0); PG8_BAR; PG8_MMA(0, 0, At, B0); PG8_MMA(0, 1, At, B1); PG8_BAR; PG8_SCHED;
            PG8_LDA(At, 1, 1); PG8_STAGE(PG8_SB(1, 0), b3, voffB); PG8_STAGE(PG8_SB(1, 1), b3 + hstep, voffB); PG8_STAGE(PG8_SA(1, 0), a3, voffA);
            PG8_WAIT_V(8); PG8_WAIT_L(0); PG8_BAR; PG8_MMA(1, 0, At, B0); PG8_MMA(1, 1, At, B1); PG8_BAR; PG8_SCHED;
            } else {
            PG8_LDB(B0, 0, 0); PG8_SCHED; PG8_LDA(At, 0, 0); PG8_STAGE(PG8_SA(1, 1), a1 + hstep, voffA);
            PG8_WAIT_L(8); PG8_BAR; PG8_WAIT_L(0); PG8_MMA(0, 0, At, B0); PG8_BAR; PG8_SCHED;
            PG8_LDB(B1, 0, 1); PG8_STAGE(PG8_SB(0, 0), b2, voffB);
            PG8_BAR; PG8_WAIT_L(0); PG8_MMA(0, 1, At, B1); PG8_BAR;
            PG8_LDA(At, 0, 1); PG8_STAGE(PG8_SA(0, 0), a2, voffA);
            PG8_BAR; PG8_WAIT_L(0); PG8_MMA(1, 0, At, B0); PG8_BAR; PG8_SCHED;
            PG8_STAGE(PG8_SB(0, 1), b2 + hstep, voffB);
            PG8_WAIT_V(6); PG8_BAR; PG8_MMA(1, 1, At, B1); PG8_BAR;
            PG8_LDB(B0, 1, 0); PG8_SCHED; PG8_LDA(At, 1, 0); PG8_STAGE(PG8_SA(0, 1), a2 + hstep, voffA);
            PG8_WAIT_L(8); PG8_BAR; PG8_WAIT_L(0); PG8_MMA(0, 0, At, B0); PG8_BAR; PG8_SCHED;
            PG8_LDB(B1, 1, 1); PG8_STAGE(PG8_SB(1, 0), b3, voffB);
            PG8_BAR; PG8_WAIT_L(0); PG8_MMA(0, 1, At, B1); PG8_BAR;
            PG8_LDA(At, 1, 1); PG8_STAGE(PG8_SA(1, 0), a3, voffA);
            PG8_BAR; PG8_WAIT_L(0); PG8_MMA(1, 0, At, B0); PG8_BAR; PG8_SCHED;
            PG8_STAGE(PG8_SB(1, 1), b3 + hstep, voffB);
            PG8_WAIT_V(6); PG8_BAR; PG8_MMA(1, 1, At, B1); PG8_BAR;
            }
        }
        if constexpr (ALIGN_EPI) { if (wr == 0) PG8_BAR; }
        if constexpr (!Epi::AFTER_DRAIN) { E(acc, cur, wr, wc, fr, fq); S.done(cur); }
        if (!has_next) break;
#pragma unroll
        for (int a = 0; a < 2; ++a)
#pragma unroll
            for (int b = 0; b < 2; ++b)
#pragma unroll
                for (int m = 0; m < 4; ++m)
#pragma unroll
                    for (int n = 0; n < 2; ++n) acc[a][b][m][n] = (f32x4){0.f, 0.f, 0.f, 0.f};
        cur = nxt; cA = nA; cB = nB; ++ui;
        if constexpr (ALIGN_EPI) { if (wr == 1) PG8_BAR; }
    }
    PG8_WAIT_V(0);
    if constexpr (!ALIGN_EPI) { if (wr == 0) PG8_BAR; }
    PG8_BAR;
    if constexpr (Epi::AFTER_DRAIN) { E.fused(acc, cur, wr, wc, fr, fq, lds, wid, lane); S.done(cur); }
#undef PG8_SA
#undef PG8_SB
#undef PG8_STAGE
#undef PG8_LDA
#undef PG8_LDB
#undef PG8_MMA
#undef PG8_WAIT_V
#undef PG8_WAIT_L
#undef PG8_BAR
#undef PG8_SCHED
}
}

#include <hip/hip_bf16.h>
#include <cmath>
namespace attn_body {
using bf16=__hip_bfloat16;
using bf16x8=__attribute__((ext_vector_type(8)))short;
using s16x4=__attribute__((ext_vector_type(4)))short;
using f32x16=__attribute__((ext_vector_type(16)))float;
using u32x4=__attribute__((ext_vector_type(4)))unsigned;
constexpr int BATCH=4,NHEAD=8,SEQ=4096,D=64,DM=2048;
constexpr int NW=8,QBLK=32,QB=QBLK*NW,KVBLK=64,NQB=SEQ/QB;
constexpr int ATTN_PITCH=DM, ATTN_UNIT_ROWS=QB;
__device__ __forceinline__ int crow(int r,int hi){return (r&3)+8*(r>>2)+4*hi;}
#define SBAR() __builtin_amdgcn_sched_barrier(0)
__device__ __forceinline__ void cmask(f32x16&p0,f32x16&p1,int jb,int qrel,int hi){
  const float NEG=-INFINITY; int kb=64*jb+4*hi;
  #pragma unroll
  for(int r=0;r<16;++r){int kv=kb+(r&3)+8*(r>>2); if(kv>qrel)p0[r]=NEG; if(kv+32>qrel)p1[r]=NEG;}
}

constexpr int NSLOT=3, SLOTB=8192;
constexpr int LDS_K=0, LDS_V=NSLOT*SLOTB, LDS_WS=2*NSLOT*SLOTB, LDS_OST=LDS_WS+NW*64*4, LDS_BYTES=LDS_OST+NW*4096;
constexpr float C2=0.125f*1.4426950408889634f;
__device__ __forceinline__ void glds16(const void*gsrc,unsigned lds_dst){unsigned keep;
  asm volatile("s_mov_b32 %0, m0\n\ts_mov_b32 m0, %2\n\ts_nop 0\n\tglobal_load_lds_dwordx4 %1, off\n\ts_mov_b32 m0, %0":"=&s"(keep):"v"(gsrc),"s"(lds_dst):"memory");}
__device__ __forceinline__ float max3f(float a,float b,float c){float r;asm("v_max3_f32 %0, %1, %2, %3":"=v"(r):"v"(a),"v"(b),"v"(c));return r;}
__device__ __forceinline__ float max2f(float a,float b){float r;asm("v_max_f32_e32 %0, %1, %2":"=v"(r):"v"(a),"v"(b));return r;}
__device__ __forceinline__ float fadd_s(float a,float b){float r;asm("v_add_f32_e32 %0, %1, %2":"=v"(r):"v"(a),"v"(b));return r;}
__device__ __forceinline__ float fsub_s(float a,float b){float r;asm("v_sub_f32_e32 %0, %1, %2":"=v"(r):"v"(a),"v"(b));return r;}
typedef float f32x2_t __attribute__((ext_vector_type(2))); typedef __bf16 bf16x2_t __attribute__((ext_vector_type(2)));
__device__ __forceinline__ unsigned cvtpk_s(float lo,float hi){f32x2_t v={lo,hi};bf16x2_t b=__builtin_convertvector(v,bf16x2_t);return __builtin_bit_cast(unsigned,b);}
#define WAIT_BAR(N) asm volatile("s_waitcnt vmcnt(" #N ") lgkmcnt(0)\n\ts_barrier":::"memory")

__device__ __forceinline__ void qkt(f32x16&p0,f32x16&p1,const char*Kslot,const bf16x8*qr,const f32x16&i0,const f32x16&i1,int r32,int hi){
  const char*kb=Kslot+hi*1024+r32*16;
  #pragma unroll
  for(int d0=0;d0<4;++d0){
    const bf16x8 b0=*reinterpret_cast<const bf16x8*>(kb+d0*2048);
    const bf16x8 b1=*reinterpret_cast<const bf16x8*>(kb+d0*2048+512);
    if(d0==0){p0=__builtin_amdgcn_mfma_f32_32x32x16_bf16(b0,qr[0],i0,0,0,0);p1=__builtin_amdgcn_mfma_f32_32x32x16_bf16(b1,qr[0],i1,0,0,0);}
    else{p0=__builtin_amdgcn_mfma_f32_32x32x16_bf16(b0,qr[d0],p0,0,0,0);p1=__builtin_amdgcn_mfma_f32_32x32x16_bf16(b1,qr[d0],p1,0,0,0);}}
}
typedef __attribute__((address_space(3))) const char* lds_cptr;
typedef short v4i16_t __attribute__((ext_vector_type(4)));
__device__ __forceinline__ void kload8(bf16x8*kf,lds_cptr kp){
  kf[0]=*(const __attribute__((address_space(3))) bf16x8*)(kp);      kf[1]=*(const __attribute__((address_space(3))) bf16x8*)(kp+512);
  kf[2]=*(const __attribute__((address_space(3))) bf16x8*)(kp+2048); kf[3]=*(const __attribute__((address_space(3))) bf16x8*)(kp+2560);
  kf[4]=*(const __attribute__((address_space(3))) bf16x8*)(kp+4096); kf[5]=*(const __attribute__((address_space(3))) bf16x8*)(kp+4608);
  kf[6]=*(const __attribute__((address_space(3))) bf16x8*)(kp+6144); kf[7]=*(const __attribute__((address_space(3))) bf16x8*)(kp+6656);
}
__device__ __forceinline__ void kload2(bf16x8*kf,lds_cptr kp,int j){ kf[2*j]=*(const __attribute__((address_space(3))) bf16x8*)(kp+j*2048); kf[2*j+1]=*(const __attribute__((address_space(3))) bf16x8*)(kp+j*2048+512); }
__device__ __forceinline__ s16x4 vtr(lds_cptr p){ return __builtin_bit_cast(s16x4,__builtin_amdgcn_ds_read_tr16_b64_v4i16((__attribute__((address_space(3))) v4i16_t*)p)); }
__device__ __forceinline__ float rowmax(const f32x16&p0,const f32x16&p1){
  float a=max3f(p0[0],p0[1],p1[0]),b=max3f(p0[2],p0[3],p1[1]);a=max3f(a,p1[2],p1[3]);
  #pragma unroll
  for(int r=4;r<16;r+=4){a=max3f(a,p0[r],p0[r+1]);b=max3f(b,p0[r+2],p0[r+3]);a=max3f(a,p1[r],p1[r+1]);b=max3f(b,p1[r+2],p1[r+3]);}
  const float m=max2f(a,b);
  auto rr=__builtin_amdgcn_permlane32_swap(__float_as_uint(m),__float_as_uint(m),false,false);
  return max2f(__uint_as_float(rr[0]),__uint_as_float(rr[1]));
}
__device__ __forceinline__ void pv(f32x16*o,int vb,bf16x8 pa0,bf16x8 pa1,bf16x8 pa2,bf16x8 pa3){
  #pragma unroll
  for(int d0=0;d0<2;++d0){s16x4 lo[4],hi[4];
    #pragma unroll
    for(int ks=0;ks<4;++ks){
      asm volatile("ds_read_b64_tr_b16 %0,%1 offset:%c2":"=&v"(lo[ks]):"v"(vb),"i"(d0*4096+ks*1024):"memory");
      asm volatile("ds_read_b64_tr_b16 %0,%1 offset:%c2":"=&v"(hi[ks]):"v"(vb),"i"(d0*4096+ks*1024+512):"memory");}
    asm volatile("s_waitcnt lgkmcnt(0)":::"memory");SBAR();
    #define PK(k) (bf16x8){lo[k][0],lo[k][1],lo[k][2],lo[k][3],hi[k][0],hi[k][1],hi[k][2],hi[k][3]}
    o[d0]=__builtin_amdgcn_mfma_f32_32x32x16_bf16(pa0,PK(0),o[d0],0,0,0);
    o[d0]=__builtin_amdgcn_mfma_f32_32x32x16_bf16(pa1,PK(1),o[d0],0,0,0);
    o[d0]=__builtin_amdgcn_mfma_f32_32x32x16_bf16(pa2,PK(2),o[d0],0,0,0);
    o[d0]=__builtin_amdgcn_mfma_f32_32x32x16_bf16(pa3,PK(3),o[d0],0,0,0);
    #undef PK
  }
}

#ifndef ATTN_STORE16
#define ATTN_STORE16(p,v) (*(u32x4*)(p)=(v))
#endif
typedef long l64x2 __attribute__((ext_vector_type(2)));
#define MFMA8(a,b,c) __builtin_amdgcn_mfma_f32_32x32x16_bf8_bf8((a),(b),(c),0,0,0)
#define MLOAD(dst,ptr,OFF) asm volatile("global_load_dwordx4 %0, %1, off offset:" #OFF : "=v"(dst) : "v"(ptr) : "memory")
#define PIN2(a,b) asm volatile("" : "+v"(a), "+v"(b))
__device__ __forceinline__ int qperm(int s){ return 16*(s>>4)+4*((s&7)>>1)+2*((s>>3)&1)+(s&1); }
template<int THRL> __device__ __forceinline__ void attn_unit(int b,int h,int qb,const bf16*Q,const bf16*__restrict__ K,const bf16*__restrict__ V,const unsigned char*__restrict__ MB,const bf16*__restrict__ AZ,const float*__restrict__ gn,unsigned short*Y,char*shm){
  const int tid=threadIdx.x,lane=tid&63,r32=lane&31,hi=lane>>5; const int wid=__builtin_amdgcn_readfirstlane(tid>>6);
  const long rowbase=(long)b*SEQ; const int q0=qb*QB;
  const bf16*Qw=Q+(rowbase+q0+wid*QBLK)*DM+h*D;
  const bf16*Kh=K+rowbase*DM+h*D,*Vh=V+rowbase*DM+h*D;
  const unsigned lds0=(unsigned)(uintptr_t)shm;
  float*wsf=(float*)(shm+LDS_WS)+wid*64;
  const bf16*ksrc=Kh+(long)lane*DM+wid*8;
  const bf16*vsrc=Vh+(long)(16*(wid&3)+(lane>>2))*DM+(wid>>2)*32+(lane&3)*8;
  const unsigned kdst=lds0+LDS_K+wid*1024, vdst=lds0+LDS_V+wid*1024;
  #define DMA_K(t,slot) glds16(ksrc+(long)(t)*KVBLK*DM,(unsigned)__builtin_amdgcn_readfirstlane(kdst+(slot)))
  #define DMA_V(t,slot) glds16(vsrc+(long)(t)*KVBLK*DM,(unsigned)__builtin_amdgcn_readfirstlane(vdst+(slot)))
  const int vb0=(int)(lds0+LDS_V)+((lane>>4)&1)*32+(lane&3)*8+(4*hi+((lane&15)>>2))*64;
  const char*Kbase=shm+LDS_K; bf16x8 kf[8];
  const lds_cptr shm3=(lds_cptr)shm; const lds_cptr kp0=shm3+LDS_K+hi*1024+r32*16; const lds_cptr vp0=shm3+LDS_V+((lane>>4)&1)*32+(lane&3)*8+(4*hi+((lane&15)>>2))*64;
  const int NT=(q0+QB)/KVBLK;
  const unsigned char*mp=MB+(((size_t)b*128+(size_t)((q0>>5)+wid))*128)*1024+lane*16;
  u32x4 mkA0,mkA1,mkB0,mkB1;
  const long idv_=(((r32>>3)&1)==hi)?(long)(0x3CULL<<(8*(r32&7))):0L; const long id0=((r32>>4)==0)?idv_:0L, id1=((r32>>4)==1)?idv_:0L;
  MLOAD(mkA0,mp,0);MLOAD(mkA1,mp,1024);
  DMA_K(0,0);DMA_V(0,0);DMA_K(1,SLOTB);
  bf16x8 qr[4];
  #pragma unroll
  for(int d0=0;d0<4;++d0)qr[d0]=*reinterpret_cast<const bf16x8*>(&Qw[(long)qperm(r32)*DM+d0*16+hi*8]);
  float mhat=0.f,l_reg=0.f;f32x16 o[2];o[0]=f32x16{};o[1]=f32x16{};f32x16 negm; { float z_; asm volatile("v_mov_b32 %0, 0":"=v"(z_)); _Pragma("unroll") for(int r=0;r<16;++r)negm[r]=z_; } asm volatile("":"+v"(negm));
  const int qrel=wid*QBLK+r32;
  #define CMASK(P0,P1,t) do{}while(0)
  bool resc=false;
  #define START(P0,P1) do{ const float rm=rowmax(P0,P1); resc=false; \
    { const float dl=rm; mhat=fadd_s(mhat,dl); \
      _Pragma("unroll") for(int r=0;r<16;++r){P0[r]=fsub_s(P0[r],dl);P1[r]=fsub_s(P1[r],dl);} \
      _Pragma("unroll") for(int r=0;r<16;++r)negm[r]=-mhat; asm volatile("":"+v"(negm)); } \
    _Pragma("unroll") for(int r=0;r<16;++r)P0[r]=__builtin_amdgcn_exp2f(P0[r]); }while(0)
  #define RESC() do{ if(resc){ asm volatile("s_waitcnt lgkmcnt(0)":::"memory"); \
      _Pragma("unroll") for(int d_=0;d_<2;++d_) _Pragma("unroll") for(int r=0;r<16;++r)o[d_][r]*=wsf[crow(r,hi)]; } }while(0)
  f32x16 pA0,pA1,pB0,pB1;
  int sl_prev=0,sl_cur=0,sl_next=SLOTB;
  #define ROT() do{sl_prev=sl_cur;sl_cur=sl_next;sl_next=(sl_next==(NSLOT-1)*SLOTB)?0:sl_next+SLOTB;}while(0)
  DMA_K(2,2*SLOTB);
  WAIT_BAR(3);
  PIN2(mkA0,mkA1);
  { const l64x2 m0_=__builtin_bit_cast(l64x2,mkA0), m1_=__builtin_bit_cast(l64x2,mkA1); f32x16 i0_=MFMA8(m0_[0],id0,negm), i1_=MFMA8(m1_[0],id0,negm); i0_=MFMA8(m0_[1],id1,i0_); i1_=MFMA8(m1_[1],id1,i1_);
    qkt(pA0,pA1,Kbase,qr,i0_,i1_,r32,hi); }
  asm volatile("s_nop 15\n\ts_nop 7":"+v"(pA0),"+v"(pA1));
  START(pA0,pA1);
  _Pragma("unroll") for(int r=0;r<16;++r)pA1[r]=__builtin_amdgcn_exp2f(pA1[r]);
  WAIT_BAR(0);
  MLOAD(mkB0,mp+2048,0);MLOAD(mkB1,mp+2048,1024);
  DMA_K(3,0);DMA_V(1,SLOTB);
  ROT();
  kload8(kf,kp0+sl_cur);
  WAIT_BAR(2);
  PIN2(mkB0,mkB1);
  s16x4 vlo[8],vhi[8]; u32x4 pw0,pw1,pw2,pw3;
  #define PKW(P,B) cvtpk_s(P[B],P[B+1])
  #define PAF(k) __builtin_bit_cast(bf16x8,pw##k)
  #define VFR(i) (bf16x8){vlo[i][0],vlo[i][1],vlo[i][2],vlo[i][3],vhi[i][0],vhi[i][1],vhi[i][2],vhi[i][3]}
  #define PIN(x) asm volatile("":"+v"(x))
  #define MX3(a,b,c) __builtin_fmaxf(__builtin_fmaxf((a),(b)),(c))
  #define GAPA(MF,A0,A1,A2,A3,W0,W1,PW) do{ MF; sacc+=A0; sacc+=A1; sacc+=A2; sacc+=A3; PIN(sacc); W0; W1; PIN(PW); SBAR(); }while(0)
  #define EX(v) __builtin_amdgcn_exp2f(v)
  #define GAPB(MF,X,B) do{ MF; X[B]=EX(X[B]); X[B+1]=EX(X[B+1]); X[B+2]=EX(X[B+2]); X[B+3]=EX(X[B+3]); PIN(X); SBAR(); }while(0)
  #define VRD(i) do{ vlo[i]=vtr(vp_+(((i)>>2)*4096+((i)&3)*1024)); vhi[i]=vtr(vp_+(((i)>>2)*4096+((i)&3)*1024+512)); }while(0)
  #define KRD(G,j) do{ if(G){ kload2(kf,kp0+sl_next,j); SBAR(); } }while(0)
  #define STEP(C0,C1,P0,P1,t,GK,GV,GL,MC0,MC1,MN0,MN1) do{ SBAR(); \
    const lds_cptr vp_=vp0+sl_prev; \
    { const l64x2 m0_=__builtin_bit_cast(l64x2,MC0), m1_=__builtin_bit_cast(l64x2,MC1); C0=MFMA8(m0_[0],id0,negm); C1=MFMA8(m1_[0],id0,negm); C0=MFMA8(m0_[1],id1,C0); C1=MFMA8(m1_[1],id1,C1); } SBAR(); \
    VRD(0); SBAR(); float sacc=(P0[0]+P0[1]); \
    GAPA(C0=__builtin_amdgcn_mfma_f32_32x32x16_bf16(kf[0],qr[0],C0,0,0,0), P0[2],P0[3],P0[4],P0[5],     pw0[0]=PKW(P0,0), pw0[1]=PKW(P0,2), pw0); \
    VRD(4); SBAR(); GAPA(C1=__builtin_amdgcn_mfma_f32_32x32x16_bf16(kf[1],qr[0],C1,0,0,0), P0[6],P0[7],P0[8],P0[9],     pw0[2]=PKW(P0,4), pw0[3]=PKW(P0,6), pw0); \
    VRD(1); SBAR(); GAPA(C0=__builtin_amdgcn_mfma_f32_32x32x16_bf16(kf[2],qr[1],C0,0,0,0),   P0[10],P0[11],P0[12],P0[13], pw1[0]=PKW(P0,8), pw1[1]=PKW(P0,10), pw1); \
    VRD(5); SBAR(); GAPA(C1=__builtin_amdgcn_mfma_f32_32x32x16_bf16(kf[3],qr[1],C1,0,0,0),   P0[14],P0[15],P1[0],P1[1],   pw1[2]=PKW(P0,12),pw1[3]=PKW(P0,14), pw1); \
    VRD(2); SBAR(); GAPA(C0=__builtin_amdgcn_mfma_f32_32x32x16_bf16(kf[4],qr[2],C0,0,0,0),   P1[2],P1[3],P1[4],P1[5],     pw2[0]=PKW(P1,0), pw2[1]=PKW(P1,2), pw2); \
    VRD(6); SBAR(); GAPA(C1=__builtin_amdgcn_mfma_f32_32x32x16_bf16(kf[5],qr[2],C1,0,0,0),   P1[6],P1[7],P1[8],P1[9],     pw2[2]=PKW(P1,4), pw2[3]=PKW(P1,6), pw2); \
    VRD(3); SBAR(); GAPA(C0=__builtin_amdgcn_mfma_f32_32x32x16_bf16(kf[6],qr[3],C0,0,0,0),   P1[10],P1[11],P1[12],P1[13], pw3[0]=PKW(P1,8), pw3[1]=PKW(P1,10), pw3); \
    VRD(7); SBAR(); GAPA(C1=__builtin_amdgcn_mfma_f32_32x32x16_bf16(kf[7],qr[3],C1,0,0,0),   P1[14],P1[15],0.f,0.f,       pw3[2]=PKW(P1,12),pw3[3]=PKW(P1,14), pw3); \
    l_reg+=sacc; \
    if(GV){MLOAD(MN0,mp+(size_t)((t)+1)*2048,0);MLOAD(MN1,mp+(size_t)((t)+1)*2048,1024);} if(GK){DMA_K((t)+3,sl_cur);} if(GV){DMA_V((t)+1,sl_next);} \
    { float a=MX3(C0[0],C0[1],C1[0]),b=MX3(C0[2],C0[3],C1[1]); a=MX3(a,C1[2],C1[3]); \
      _Pragma("unroll") for(int r=4;r<16;r+=4){a=MX3(a,C0[r],C0[r+1]);b=MX3(b,C0[r+2],C0[r+3]);a=MX3(a,C1[r],C1[r+1]);b=MX3(b,C1[r+2],C1[r+3]);} \
      float rm=__builtin_fmaxf(a,b); { auto rr=__builtin_amdgcn_permlane32_swap(__float_as_uint(rm),__float_as_uint(rm),false,false); rm=__builtin_fmaxf(__uint_as_float(rr[0]),__uint_as_float(rr[1])); } \
      resc=false; \
      if(__builtin_expect(__any(rm>(float)THRL),0)){ const float dl=__builtin_fmaxf(rm,0.f); mhat+=dl; \
        _Pragma("unroll") for(int r=0;r<16;++r){C0[r]-=dl;C1[r]-=dl;} \
        _Pragma("unroll") for(int r=0;r<16;++r)negm[r]=-mhat; asm volatile("":"+v"(negm)); \
        const float f=__builtin_amdgcn_exp2f(-dl); l_reg*=f; if(hi==0)wsf[r32]=f; resc=true; } } \
    SBAR(); \
    GAPB(o[0]=__builtin_amdgcn_mfma_f32_32x32x16_bf16(PAF(0),VFR(0),o[0],0,0,0), C0,0); \
    GAPB(o[1]=__builtin_amdgcn_mfma_f32_32x32x16_bf16(PAF(0),VFR(4),o[1],0,0,0), C0,4); \
    KRD(GL,0); GAPB(o[0]=__builtin_amdgcn_mfma_f32_32x32x16_bf16(PAF(1),VFR(1),o[0],0,0,0), C0,8); \
    KRD(GL,1); GAPB(o[1]=__builtin_amdgcn_mfma_f32_32x32x16_bf16(PAF(1),VFR(5),o[1],0,0,0), C0,12); \
    KRD(GL,2); GAPB(o[0]=__builtin_amdgcn_mfma_f32_32x32x16_bf16(PAF(2),VFR(2),o[0],0,0,0), C1,0); \
    KRD(GL,3); GAPB(o[1]=__builtin_amdgcn_mfma_f32_32x32x16_bf16(PAF(2),VFR(6),o[1],0,0,0), C1,4); \
    GAPB(o[0]=__builtin_amdgcn_mfma_f32_32x32x16_bf16(PAF(3),VFR(3),o[0],0,0,0), C1,8); \
    GAPB(o[1]=__builtin_amdgcn_mfma_f32_32x32x16_bf16(PAF(3),VFR(7),o[1],0,0,0), C1,12); \
    }while(0)
  int t=1;
  #undef CMASK
  #define CMASK(P0,P1,t) do{}while(0)
  for(;t+5<NT;t+=2){
    STEP(pB0,pB1,pA0,pA1,t,true,true,true,mkB0,mkB1,mkA0,mkA1);     WAIT_BAR(2); PIN2(mkA0,mkA1); RESC(); ROT();
    STEP(pA0,pA1,pB0,pB1,t+1,true,true,true,mkA0,mkA1,mkB0,mkB1);   WAIT_BAR(2); PIN2(mkB0,mkB1); RESC(); ROT();
  }
  #undef CMASK
  #define CMASK(P0,P1,t) do{}while(0)
  #define ENDW(tt) do{ if((tt)+3<NT){WAIT_BAR(2);} else if((tt)+2<NT){WAIT_BAR(1);} else {WAIT_BAR(0);} }while(0)
  for(;t+1<NT;t+=2){
    STEP(pB0,pB1,pA0,pA1,t,(t+3<NT),(t+1<NT),(t+1<NT),mkB0,mkB1,mkA0,mkA1);       ENDW(t);   PIN2(mkA0,mkA1); RESC(); ROT();
    STEP(pA0,pA1,pB0,pB1,t+1,(t+4<NT),(t+2<NT),(t+2<NT),mkA0,mkA1,mkB0,mkB1);     ENDW(t+1); PIN2(mkB0,mkB1); RESC(); ROT();
  }
  STEP(pB0,pB1,pA0,pA1,NT-1,false,false,false,mkB0,mkB1,mkA0,mkA1); RESC();
  { float sacc=pB0[0]+pB0[1]; _Pragma("unroll") for(int r=2;r<16;++r)sacc+=pB0[r]; _Pragma("unroll") for(int r=0;r<16;++r)sacc+=pB1[r]; l_reg+=sacc;
    pw0=(u32x4){PKW(pB0,0),PKW(pB0,2),PKW(pB0,4),PKW(pB0,6)};pw1=(u32x4){PKW(pB0,8),PKW(pB0,10),PKW(pB0,12),PKW(pB0,14)};pw2=(u32x4){PKW(pB1,0),PKW(pB1,2),PKW(pB1,4),PKW(pB1,6)};pw3=(u32x4){PKW(pB1,8),PKW(pB1,10),PKW(pB1,12),PKW(pB1,14)};
    SBAR(); pv(o,vb0+sl_cur,PAF(0),PAF(1),PAF(2),PAF(3)); }
  #undef PKW
  #undef PAF
  #undef VFR
  #undef PIN
  #undef MX3
  #undef GAPA
  #undef GAPB
  #undef EX
  #undef VRD
  #undef KRD
  #undef STEP
  #undef ENDW
  {auto rr=__builtin_amdgcn_permlane32_swap(__float_as_uint(l_reg),__float_as_uint(l_reg),false,false);l_reg=__uint_as_float(rr[0])+__uint_as_float(rr[1]);}
  if(hi==0)wsf[32+r32]=l_reg;asm volatile("s_waitcnt lgkmcnt(0)":::"memory");
  float rli[16];
  #pragma unroll
  for(int r=0;r<16;++r)rli[r]=__builtin_amdgcn_rcpf(wsf[32+crow(r,hi)]);
  { bf16*stg=(bf16*)(shm+LDS_OST)+wid*2048;
    #pragma unroll
    for(int r=0;r<16;++r){const int orow=crow(r,hi);
      #pragma unroll
      for(int d0=0;d0<2;++d0)stg[orow*64+d0*32+r32]=__float2bfloat16(o[d0][r]*rli[r]);}
    asm volatile("s_waitcnt lgkmcnt(0)":::"memory");
    const long grow0=rowbase+q0+wid*QBLK;
    #pragma unroll
    for(int i=0;i<4;++i){const int row=i*8+(lane>>3),ch=lane&7; const u32x4 v=*(const u32x4*)(stg+row*64+ch*8);
      const long grow=grow0+qperm(row);
      const u32x4 az=*(const u32x4*)(AZ+grow*DM+h*D+ch*8);
      const float4 g0=*(const float4*)(gn+h*D+ch*8), g1=*(const float4*)(gn+h*D+ch*8+4);
      float x[8],z[8];
      #pragma unroll
      for(int e=0;e<4;++e){x[2*e]=__uint_as_float(v[e]<<16);x[2*e+1]=__uint_as_float(v[e]&0xffff0000u);z[2*e]=__uint_as_float(az[e]<<16);z[2*e+1]=__uint_as_float(az[e]&0xffff0000u);}
      float ss=0.f;
      #pragma unroll
      for(int e=0;e<8;++e)ss+=x[e]*x[e];
      ss+=__shfl_xor(ss,1);ss+=__shfl_xor(ss,2);ss+=__shfl_xor(ss,4);
      const float inv=1.f/sqrtf(ss*(1.f/64.f)+1e-6f);
      const float gg[8]={g0.x,g0.y,g0.z,g0.w,g1.x,g1.y,g1.z,g1.w};
      unsigned short hv[8];
      #pragma unroll
      for(int e=0;e<8;++e){const float y=x[e]*inv*gg[e]*(z[e]/(1.f+__expf(-z[e]))); hv[e]=__builtin_bit_cast(unsigned short,(_Float16)y);}
      u32x4 ov; ov[0]=hv[0]|((unsigned)hv[1]<<16);ov[1]=hv[2]|((unsigned)hv[3]<<16);ov[2]=hv[4]|((unsigned)hv[5]<<16);ov[3]=hv[6]|((unsigned)hv[7]<<16);
      *(u32x4*)(Y+grow*1024+512+h*D+ch*8)=ov;} }
  asm volatile("s_waitcnt lgkmcnt(0)\n\ts_barrier":::"memory");
  #undef DMA_K
  #undef DMA_V
  #undef CMASK
  #undef START
  #undef RESC
  #undef ROT
}
constexpr int ATTN_LDS_BYTES=LDS_BYTES;
struct AttnTensors { const bf16* Q; const bf16* K; const bf16* V; const unsigned char* MB; const bf16* AZ; const float* gn; unsigned short* Y; };
struct AttnUnit { int bh; int qb; };
struct StaticOrder {
  int vcu;
  __device__ __forceinline__ explicit StaticOrder(int grid,int block):vcu((block%8)*(grid/8)+block/8){}
  __device__ __forceinline__ bool next(int i,AttnUnit&u)const{ if(i>=2)return false; const int s=vcu&7; u.bh=vcu>>3; u.qb=(i==0)?s:15-s; return true; }
  __device__ __forceinline__ void a_ready(const AttnUnit&)const{}
  __device__ __forceinline__ void done(const AttnUnit&)const{}
};
template<class Sched,int THRL=8> __device__ __forceinline__ void attn_phase(char*lds,const AttnTensors&T,const Sched&S){
  AttnUnit u;
  for(int i=0;S.next(i,u);++i){ S.a_ready(u); attn_unit<THRL>(u.bh/NHEAD,u.bh%NHEAD,u.qb,T.Q,T.K,T.V,T.MB,T.AZ,T.gn,T.Y,lds); S.done(u); }
}
#undef SBAR
#undef WAIT_BAR
}

#define GAS __attribute__((address_space(1)))
#define LAS __attribute__((address_space(3)))
typedef unsigned short bf16;
typedef unsigned v4u __attribute__((ext_vector_type(4)));
typedef float f32x4 __attribute__((ext_vector_type(4)));
typedef short bf16x8 __attribute__((ext_vector_type(8)));
typedef GAS unsigned gu32;
typedef GAS unsigned long long gu64;
#define RLX_AGENT __ATOMIC_RELAXED, __HIP_MEMORY_SCOPE_AGENT
#define LDS_WAIT() asm volatile("s_waitcnt lgkmcnt(0)" ::: "memory")
#define VM_WAIT() asm volatile("s_waitcnt vmcnt(0)" ::: "memory")
__device__ __forceinline__ unsigned long long rt() { return __builtin_amdgcn_s_memrealtime(); }
__device__ __forceinline__ unsigned f2bf(float f) { unsigned u = __builtin_bit_cast(unsigned, f); return (u + 0x7fffu + ((u >> 16) & 1u)) >> 16; }
__device__ __forceinline__ unsigned pk2(float lo, float hi) { return f2bf(lo) | (f2bf(hi) << 16); }

#define XB_TMO      128
#define XB_XCNT(j)  (256  + 64 * (j))
#define XB_XSUB(j)  (1280 + 64 * (j))
#define XB_XGEN(j)  (2304 + 64 * (j))
#define XB_TOP      3328
#define XB_TOPGEN   3392
#define XCD_BAR_WORDS 3456
#define XB_SPIN_CAP (1u << 18)

__device__ __forceinline__ unsigned xb_ld(unsigned* p)              { return __hip_atomic_load(p, __ATOMIC_RELAXED, __HIP_MEMORY_SCOPE_AGENT); }
__device__ __forceinline__ unsigned xb_add(unsigned* p, unsigned v) { return __hip_atomic_fetch_add(p, v, __ATOMIC_RELAXED, __HIP_MEMORY_SCOPE_AGENT); }
__device__ __forceinline__ unsigned xb_xcc_id() { return (unsigned)__builtin_amdgcn_s_getreg((3 << 11) | 20) & 0xFu; }
#define XB_SPIN(cond, bar) do { unsigned _sp = 0; while (cond) { __builtin_amdgcn_s_sleep(1); \
    if ((++_sp & 255u) == 0u) { if (xb_ld(&(bar)[XB_TMO])) break; if (_sp > XB_SPIN_CAP) { atomicAdd(&(bar)[XB_TMO], 1u); break; } } } } while (0)

struct XcdBarrier {
    unsigned* bar; unsigned x;
    volatile LAS unsigned* st;
};

__device__ __forceinline__ XcdBarrier xcd_barrier_post(unsigned* bar, volatile LAS unsigned* st) {
    XcdBarrier b; b.bar = bar; b.x = xb_xcc_id(); b.st = st;
    if (threadIdx.x == 0) (void)xb_add(&bar[XB_XCNT(b.x)], 1u);
    return b;
}
__device__ __forceinline__ void xcd_barrier_complete(unsigned* bar, unsigned x, unsigned& nloc, unsigned& nx) {
    const unsigned G = gridDim.x * gridDim.y * gridDim.z;
    unsigned sum, cnt, mine, sp = 0u;
    for (;;) {
        sum = 0u; cnt = 0u; mine = 0u;
#pragma unroll
        for (unsigned j = 0; j < 16; ++j) { const unsigned c = xb_ld(&bar[XB_XCNT(j)]); sum += c; cnt += (c > 0u) ? 1u : 0u; mine = (j == x) ? c : mine; }
        if (sum == G) break;
        __builtin_amdgcn_s_sleep(1);
        if ((++sp & 255u) == 0u) { if (xb_ld(&bar[XB_TMO])) break; if (sp > XB_SPIN_CAP) { atomicAdd(&bar[XB_TMO], 1u); break; } }
    }
    nloc = mine > 0u ? mine : 1u; nx = cnt > 0u ? cnt : 1u;
}

__device__ __forceinline__ void xcd_barrier(const XcdBarrier& b) {
    asm volatile("s_waitcnt vmcnt(0)" ::: "memory");
    __syncthreads();
    if (threadIdx.x == 0) {
        unsigned* bar = b.bar;
        __builtin_amdgcn_s_waitcnt(0);
        unsigned nloc = b.st[0], nx = b.st[1];
        if (nloc == 0u) { xcd_barrier_complete(bar, b.x, nloc, nx); b.st[0] = nloc; b.st[1] = nx; }
        const unsigned old = xb_add(&bar[XB_XSUB(b.x)], 1u);
        const unsigned gen = old / nloc;
        if (old + 1u == (gen + 1u) * nloc) {
            __builtin_amdgcn_fence(__ATOMIC_RELEASE, "agent");
            asm volatile("s_waitcnt vmcnt(0)" ::: "memory");
            const unsigned og = xb_add(&bar[XB_TOP], 1u);
            const unsigned tg = og / nx;
            if (og + 1u == (tg + 1u) * nx) xb_add(&bar[XB_TOPGEN], 1u);
            else XB_SPIN(xb_ld(&bar[XB_TOPGEN]) == tg, bar);
            __builtin_amdgcn_fence(__ATOMIC_ACQUIRE, "agent");
            xb_add(&bar[XB_XGEN(b.x)], 1u);
            asm volatile("s_waitcnt vmcnt(0)" ::: "memory");
        } else {
            XB_SPIN(xb_ld(&bar[XB_XGEN(b.x)]) == gen, bar);
            __builtin_amdgcn_fence(__ATOMIC_ACQUIRE, "agent");
            asm volatile("s_waitcnt vmcnt(0)" ::: "memory");
        }
    }
    __syncthreads();
}

constexpr int NWAVES = 8;
#ifndef MK_N_LAUNCHES
#define MK_N_LAUNCHES 1
#endif
constexpr int PER_PHASE = 9;
constexpr int N_LAUNCHES = MK_N_LAUNCHES;

constexpr int BATCH = 4, T = 4096, D = 1024, M = BATCH * T;
constexpr int NHEAD = 8, HD = 64, TOPK = 256;
constexpr int D_IN = 4680, NPROJ = 4864;
constexpr int C_CB = 0, C_CC = 512, C_CU = 1024, C_CZ = 1536, C_Q = 2048, C_K = 2560, C_V = 3072, C_AZ = 3584, C_IQ = 4096, C_IK = 4608, C_IW = 4672;
constexpr float EPS = 1e-6f;
constexpr float C2 = 0.125f * 1.4426950408889634f;
constexpr float IWSCALE = 0.35355339059327373f * 0.125f;

constexpr size_t MiB = 1u << 20;
constexpr size_t WS_CTL = 0, CTL_ZERO_BYTES = 1 * MiB;
constexpr size_t WS_ROPE = 1 * MiB;
constexpr size_t WS_IW = 2 * MiB;
constexpr size_t WS_WIN = 4 * MiB;
constexpr size_t WS_WOUT = 14 * MiB;
constexpr size_t WS_H = 16 * MiB;
constexpr size_t WS_YCAT = WS_H;
constexpr size_t WS_CONV = 48 * MiB;
constexpr size_t WS_MASKB = WS_CONV;
constexpr size_t WS_ATT = 112 * MiB;
constexpr size_t WS_IDX = 176 * MiB;
constexpr size_t WS_MASK = 200 * MiB;
constexpr size_t WS_END = 208 * MiB;
constexpr int CW_TMO = 0, CW_CODE = 1, CW_BAR = 4096, CW_MOD = 131072;
static_assert((CW_MOD + BATCH * 3 * D) * 4 <= (int)CTL_ZERO_BYTES, "ctl map");

constexpr int RING_OFF = 0, RING_BYTES = 147456;
constexpr int LDSCTL_OFF = RING_BYTES, MISC_OFF = LDSCTL_OFF + 320;
constexpr int LDS_BYTES = RING_BYTES + 1024;

typedef unsigned short u16;
__device__ __forceinline__ float bf2f(u16 v) { return __uint_as_float((unsigned)v << 16); }
__device__ __forceinline__ float h2f(u16 v) { return (float)__builtin_bit_cast(_Float16, v); }
__device__ __forceinline__ u16 f2h(float f) { return __builtin_bit_cast(u16, (_Float16)f); }
__device__ __forceinline__ unsigned pk2h(float lo, float hi) { return (unsigned)f2h(lo) | ((unsigned)f2h(hi) << 16); }
__device__ __forceinline__ float siluf(float z) { return z / (1.f + __expf(-z)); }

struct Args { const void* in[13]; float* out; unsigned char* ws; float if0, if1, if2, if3, if4, if5, if6, if7; int ph_lo, ph_hi; };
struct Frame {
    LAS unsigned char* lds;
    volatile LAS unsigned* MISC;
    gu32* ctl;
    int tid, lane, wave, vcu, G;
    const float *x, *c, *w_ada, *b_ada, *norm_in, *w_in, *conv_w, *conv_b, *gn_conv, *gn_attn, *w_out, *norm_f; const int* positions;
    float* out; float* MOD; float* ROPE; float* IW;
    u16 *WIN, *WOUT, *H, *CONV, *ATT, *IDX, *YCAT; unsigned* MASK; unsigned char* MASKB;
};
__device__ __forceinline__ float wave_sum(float v) {
#pragma unroll
    for (int o = 1; o < 64; o <<= 1) v += __shfl_xor(v, o);
    return v;
}
__device__ __forceinline__ int wave_sum_i(int v) {
#pragma unroll
    for (int o = 1; o < 64; o <<= 1) v += __shfl_xor(v, o);
    return v;
}
__device__ __forceinline__ float wave_max(float v) {
#pragma unroll
    for (int o = 1; o < 64; o <<= 1) v = fmaxf(v, __shfl_xor(v, o));
    return v;
}
__device__ __forceinline__ void p0_transpose_item(const float* W, int K, int N, int Npad, u16* WT, LAS float* scr, int item, int lane) {
    const int nblk = Npad / 32, kb = item / nblk, nb = item % nblk, k0 = 64 * kb, n0 = 32 * nb;
    const int n_in = n0 + (lane & 31);
#pragma unroll 8
    for (int i = 0; i < 32; ++i) { const int kk = 2 * i + (lane >> 5); scr[kk * 33 + (lane & 31)] = (n_in < N) ? W[(size_t)(k0 + kk) * N + n_in] : 0.f; }
    LDS_WAIT(); asm volatile("" ::: "memory");
    const int c = lane & 7;
#pragma unroll
    for (int j = 0; j < 4; ++j) { const int n = (lane >> 3) + 8 * j; const LAS float* s = scr + (8 * c) * 33 + n;
        v4u o; o.x = pk2h(s[0 * 33], s[1 * 33]); o.y = pk2h(s[2 * 33], s[3 * 33]); o.z = pk2h(s[4 * 33], s[5 * 33]); o.w = pk2h(s[6 * 33], s[7 * 33]);
        *(GAS v4u*)(WT + (size_t)(n0 + n) * K + k0 + 8 * c) = o; }
    LDS_WAIT(); asm volatile("" ::: "memory");
}
__device__ __forceinline__ void sincos_acc(float ang, float& sn, float& cs) {
    double rev = (double)ang * 0.15915494309189535; rev -= floor(rev);
    const int q = (int)(rev * 4.0 + 0.5);
    const float th = (float)((rev - 0.25 * (double)q) * 6.283185307179586);
    const float t2 = th * th;
    const float s = th * (1.f + t2 * (-1.f / 6.f + t2 * (1.f / 120.f + t2 * (-1.f / 5040.f + t2 * (1.f / 362880.f)))));
    const float c = 1.f + t2 * (-0.5f + t2 * (1.f / 24.f + t2 * (-1.f / 720.f + t2 * (1.f / 40320.f))));
    switch (q & 3) { case 0: sn = s; cs = c; break; case 1: sn = c; cs = -s; break; case 2: sn = -s; cs = -c; break; default: sn = -c; cs = s; break; }
}

__device__ __forceinline__ void p0_prologue(Frame& F, const Args& A) {
    LAS float* scr = (LAS float*)(F.lds + RING_OFF + F.wave * 16384);
    const int gw = F.vcu * NWAVES + F.wave, NGW = F.G * NWAVES;
    constexpr int I_IN = (D / 64) * (NPROJ / 32), I_OUT = (D / 64) * (D / 32), I_MOD = 32 * 48;
    constexpr int NITEMS = I_IN + I_OUT + I_MOD;
    for (int it = gw; it < NITEMS; it += NGW) {
        int r = it;
        if (r < I_IN) { p0_transpose_item(F.w_in, D, D_IN, NPROJ, F.WIN, scr, r, F.lane); continue; } r -= I_IN;
        if (r < I_OUT) { p0_transpose_item(F.w_out, D, D, D, F.WOUT, scr, r, F.lane); continue; } r -= I_OUT;
        {
            const int kc = r / 48, cg = r % 48, col = cg * 64 + F.lane;
            float sv[BATCH];
#pragma unroll
            for (int b = 0; b < BATCH; ++b) sv[b] = siluf(F.c[b * D + kc * 32 + (F.lane & 31)]);
            float acc[BATCH];
#pragma unroll
            for (int b = 0; b < BATCH; ++b) acc[b] = (kc == 0) ? F.b_ada[col] : 0.f;
#pragma unroll 8
            for (int kk = 0; kk < 32; ++kk) { const float wv = F.w_ada[(size_t)(kc * 32 + kk) * (3 * D) + col];
#pragma unroll
                for (int b = 0; b < BATCH; ++b) acc[b] += __shfl(sv[b], kk) * wv; }
#pragma unroll
            for (int b = 0; b < BATCH; ++b) atomicAdd(F.MOD + b * 3 * D + col, acc[b]);
        }
    }
    const int ri = F.lane & 7;
    const float ifr = ri == 0 ? A.if0 : ri == 1 ? A.if1 : ri == 2 ? A.if2 : ri == 3 ? A.if3 : ri == 4 ? A.if4 : ri == 5 ? A.if5 : ri == 6 ? A.if6 : A.if7;
    for (int e = (gw * 64 + F.lane); e < M * 8; e += NGW * 64) { const int m = e >> 3, i = e & 7;
        const float ang = (float)F.positions[m] * ifr; float sn, cs; sincos_acc(ang, sn, cs);
        F.ROPE[m * 16 + i] = cs; F.ROPE[m * 16 + 8 + i] = sn; }
}
__device__ __forceinline__ void p1_rows(Frame& F) {
    const int gw = F.vcu * NWAVES + F.wave, NGW = F.G * NWAVES;
    for (int m = gw; m < M; m += NGW) {
        const int b = m / T;
        const GAS f32x4* xr = (const GAS f32x4*)(F.x + (size_t)m * D) + F.lane;
        f32x4 v[4]; float s = 0.f;
#pragma unroll
        for (int j = 0; j < 4; ++j) { v[j] = xr[64 * j]; s += (v[j].x * v[j].x + v[j].y * v[j].y) + (v[j].z * v[j].z + v[j].w * v[j].w); }
        const float inv = 1.f / sqrtf(wave_sum(s) * (1.f / D) + EPS);
        GAS unsigned long long* o8 = (GAS unsigned long long*)(F.H + (size_t)m * D) + F.lane;
#pragma unroll
        for (int j = 0; j < 4; ++j) { const int col = 4 * F.lane + 256 * j;
            const f32x4 g = *(const f32x4*)(F.norm_in + col), sh = *(const f32x4*)(F.MOD + b * 3 * D + col), sc = *(const f32x4*)(F.MOD + b * 3 * D + D + col);
            const f32x4 h = (v[j] * inv) * g * (sc + 1.f) + sh;
            o8[64 * j] = (unsigned long long)pk2h(h.x, h.y) | ((unsigned long long)pk2h(h.z, h.w) << 32); }
    }
}
__device__ __forceinline__ void p3_rows(Frame& F) {
    const int gw = F.vcu * NWAVES + F.wave, NGW = F.G * NWAVES, lane = F.lane;
    for (int m = gw; m < M; m += NGW) {
        const int t = m % T;
        u16* arow = F.ATT + (size_t)m * 2048; u16* irow = F.IDX + (size_t)m * 768; const u16* prow = F.CONV + (size_t)m * 2048;
        const int h = lane >> 3, i = lane & 7;
        const float cs = F.ROPE[m * 16 + i], sn = F.ROPE[m * 16 + 8 + i];
        { u16* p = arow + h * 64; const float x1 = bf2f(p[i]), x2 = bf2f(p[8 + i]); p[i] = (u16)f2bf(x1 * cs - x2 * sn); p[8 + i] = (u16)f2bf(x1 * sn + x2 * cs); }
        { u16* p = arow + 512 + h * 64; const float x1 = bf2f(p[i]), x2 = bf2f(p[8 + i]); p[i] = (u16)f2bf(x1 * cs - x2 * sn); p[8 + i] = (u16)f2bf(x1 * sn + x2 * cs); }
        { u16* p = irow + h * 64; const float x1 = h2f(p[i]), x2 = h2f(p[8 + i]); p[i] = f2h(x1 * cs - x2 * sn); p[8 + i] = f2h(x1 * sn + x2 * cs); }
        if (h == 0) { u16* p = irow + 512; const float x1 = h2f(p[i]), x2 = h2f(p[8 + i]); p[i] = f2h(x1 * cs - x2 * sn); p[8 + i] = f2h(x1 * sn + x2 * cs); }
        const int c0 = lane * 8;
        const v4u z4 = {0u, 0u, 0u, 0u};
        const v4u cbv = *(const v4u*)(prow + C_CB + c0), czv = *(const v4u*)(prow + C_CZ + c0);
        const v4u cc0 = *(const v4u*)(prow + C_CC + c0), cu0 = *(const v4u*)(prow + C_CU + c0);
        const v4u cc1 = t >= 1 ? *(const v4u*)(prow - 2048 + C_CC + c0) : z4, cu1 = t >= 1 ? *(const v4u*)(prow - 2048 + C_CU + c0) : z4;
        const v4u cc2 = t >= 2 ? *(const v4u*)(prow - 4096 + C_CC + c0) : z4, cu2 = t >= 2 ? *(const v4u*)(prow - 4096 + C_CU + c0) : z4;
        float y[8]; float ss = 0.f;
#pragma unroll
        for (int e = 0; e < 8; ++e) {
            const int wd = e >> 1; const bool hi = e & 1;
#define UNP(v) (hi ? __uint_as_float((v)[wd] & 0xffff0000u) : __uint_as_float((v)[wd] << 16))
            const float s0 = UNP(cc0) * UNP(cu0), s1 = UNP(cc1) * UNP(cu1), s2 = UNP(cc2) * UNP(cu2);
            const int c = c0 + e;
            const float cv = F.conv_b[c] + F.conv_w[c] * s2 + F.conv_w[512 + c] * s1 + F.conv_w[1024 + c] * s0;
            y[e] = UNP(cbv) * cv; ss += y[e] * y[e];
        }
        ss += __shfl_xor(ss, 1); ss += __shfl_xor(ss, 2); ss += __shfl_xor(ss, 4);
        const float inv = 1.f / sqrtf(ss * (1.f / 64.f) + EPS);
        float o[8];
#pragma unroll
        for (int e = 0; e < 8; ++e) { const int wd = e >> 1; const bool hi = e & 1; o[e] = y[e] * inv * F.gn_conv[c0 + e] * siluf(UNP(czv)); }
#undef UNP
        v4u ov; ov.x = pk2h(o[0], o[1]); ov.y = pk2h(o[2], o[3]); ov.z = pk2h(o[4], o[5]); ov.w = pk2h(o[6], o[7]);
        *(v4u*)(F.YCAT + (size_t)m * D + c0) = ov;
    }
}
__device__ __forceinline__ unsigned okey(float s) { const unsigned u = __float_as_uint(s); return (u & 0x80000000u) ? ~u : (u | 0x80000000u); }
__device__ __forceinline__ void p4_indexer(Frame& F) {
    const int gw = F.vcu * NWAVES + F.wave, NGW = F.G * NWAVES, lane = F.lane;
    LAS float* iqf = (LAS float*)(F.lds + RING_OFF + F.wave * 18432);
    LAS float* sc = iqf + 512;
    for (int m = gw; m < M; m += NGW) {
        const int b = m / T, t = m % T, n = t + 1;
        unsigned* mrow = F.MASK + (size_t)m * 128;
        if (n <= TOPK) {
            for (int w = lane; w < 128; w += 64) { const int k0 = 32 * w; mrow[w] = (k0 + 31 <= t) ? 0xffffffffu : (k0 > t ? 0u : ((1u << (t - k0 + 1)) - 1u)); }
            continue;
        }
        const u16* irow = F.IDX + (size_t)m * 768;
        for (int e = lane; e < 512; e += 64) iqf[e] = h2f(irow[e]);
        const float wv = (lane < 8) ? F.IW[m * 8 + lane] : 0.f;
        float wh[8];
#pragma unroll
        for (int h = 0; h < 8; ++h) wh[h] = __shfl(wv, h);
        LDS_WAIT(); asm volatile("" ::: "memory");
        for (int s = lane; s < n; s += 64) {
            const v4u* kr = (const v4u*)(F.IDX + (size_t)(b * T + s) * 768 + 512);
            float kf[64];
#pragma unroll
            for (int q = 0; q < 8; ++q) { const v4u v = kr[q];
#pragma unroll
                for (int e = 0; e < 4; ++e) { const unsigned w = v[e]; kf[q * 8 + 2 * e] = h2f((u16)(w & 0xffffu)); kf[q * 8 + 2 * e + 1] = h2f((u16)(w >> 16)); } }
            float score = 0.f;
#pragma unroll
            for (int h = 0; h < 8; ++h) { float d = 0.f;
#pragma unroll
                for (int dd = 0; dd < 64; ++dd) d = fmaf(iqf[h * 64 + dd], kf[dd], d);
                score = fmaf(wh[h], fmaxf(d, 0.f), score); }
            sc[s] = score;
        }
        LDS_WAIT(); asm volatile("" ::: "memory");
        unsigned keys[64];
#pragma unroll
        for (int j = 0; j < 64; ++j) { const int s = j * 64 + lane; keys[j] = (s < n) ? okey(sc[s]) : 0u; }
        unsigned Tk = 0u;
        for (int bit = 31; bit >= 0; --bit) { const unsigned cand = Tk | (1u << bit); int c = 0;
#pragma unroll
            for (int j = 0; j < 64; ++j) c += (keys[j] >= cand) ? 1 : 0;
            c = wave_sum_i(c); if (c >= TOPK) Tk = cand; }
        int cgt = 0;
#pragma unroll
        for (int j = 0; j < 64; ++j) cgt += (keys[j] > Tk) ? 1 : 0;
        cgt = wave_sum_i(cgt);
        const int need = TOPK - cgt; int base = 0;
        const unsigned long long ltm = (1ull << lane) - 1ull;
#pragma unroll
        for (int j = 0; j < 64; ++j) {
            const bool tie = keys[j] == Tk; const unsigned long long bl = __ballot(tie);
            const int rank = base + __popcll(bl & ltm);
            const bool sel = (keys[j] > Tk) || (tie && rank < need); base += __popcll(bl);
            const unsigned long long sb = __ballot(sel);
            if (lane == 0) { mrow[2 * j] = (unsigned)sb; mrow[2 * j + 1] = (unsigned)(sb >> 32); }
        }
        LDS_WAIT(); asm volatile("" ::: "memory");
    }
}
__device__ __forceinline__ void p5_attn(Frame& F) {
    const int gw = F.vcu * NWAVES + F.wave, NGW = F.G * NWAVES, lane = F.lane;
    LAS int* idx = (LAS int*)(F.lds + RING_OFF + F.wave * 4096);
    LAS float* qf = (LAS float*)(idx + 256);
    LAS float* pl = qf + 64;
    const unsigned long long ltm = (1ull << lane) - 1ull;
    for (int m = gw; m < M; m += NGW) {
        const int b = m / T, t = m % T;
        const unsigned* mrow = F.MASK + (size_t)m * 128;
        int base = 0;
        for (int j = 0; j <= (t >> 6); ++j) {
            const unsigned long long bm = (unsigned long long)mrow[2 * j] | ((unsigned long long)mrow[2 * j + 1] << 32);
            const bool sel = (bm >> lane) & 1ull; const int pos = base + __popcll(bm & ltm);
            if (sel && pos < TOPK) idx[pos] = j * 64 + lane;
            base += __popcll(bm);
        }
        const int nsel = base < TOPK ? base : TOPK;
        const u16* prow = F.ATT + (size_t)m * 2048;
        for (int h = 0; h < NHEAD; ++h) {
            qf[lane] = bf2f(prow[h * 64 + lane]);
            LDS_WAIT(); asm volatile("" ::: "memory");
            float lg[4]; float mx = -INFINITY;
#pragma unroll
            for (int c = 0; c < 4; ++c) { const int p = c * 64 + lane; lg[c] = -INFINITY;
                if (p < nsel) { const int s = idx[p]; const v4u* kr = (const v4u*)(F.ATT + (size_t)(b * T + s) * 2048 + 512 + h * 64); float d = 0.f;
#pragma unroll
                    for (int q = 0; q < 8; ++q) { const v4u v = kr[q];
#pragma unroll
                        for (int e = 0; e < 4; ++e) { d = fmaf(qf[q * 8 + 2 * e], __uint_as_float(v[e] << 16), d); d = fmaf(qf[q * 8 + 2 * e + 1], __uint_as_float(v[e] & 0xffff0000u), d); } }
                    lg[c] = d; }
                mx = fmaxf(mx, lg[c]); }
            mx = wave_max(mx);
            float sum = 0.f;
#pragma unroll
            for (int c = 0; c < 4; ++c) { const int p = c * 64 + lane; const float pe = (p < nsel) ? exp2f(lg[c] - mx) : 0.f; sum += pe; pl[p] = pe; }
            sum = wave_sum(sum);
            LDS_WAIT(); asm volatile("" ::: "memory");
            float acc = 0.f;
            const u16* vb = F.ATT + (size_t)(b * T) * 2048 + 1024 + h * 64 + lane;
#pragma unroll 4
            for (int p = 0; p < nsel; ++p) acc = fmaf(pl[p], bf2f(vb[(size_t)idx[p] * 2048]), acc);
            const float o = acc / sum;
            const float ssq = wave_sum(o * o);
            const float y = o * (1.f / sqrtf(ssq * (1.f / 64.f) + EPS)) * F.gn_attn[h * 64 + lane] * siluf(bf2f(prow[1536 + h * 64 + lane]));
            F.YCAT[(size_t)m * D + 512 + h * 64 + lane] = f2h(y);
            LDS_WAIT(); asm volatile("" ::: "memory");
        }
    }
}
__device__ __forceinline__ void p5_convert(Frame& F) {
    const int gw = F.vcu * NWAVES + F.wave, NGW = F.G * NWAVES, lane = F.lane, hi = lane >> 5, key = lane & 31;
    for (int blk = gw; blk < BATCH * 128 * 128; blk += NGW) {
        const int b = blk >> 14, QB = (blk >> 7) & 127, KB = blk & 127;
        if (KB > (QB | 7)) continue;
        unsigned w[4] = {0u, 0u, 0u, 0u};
#pragma unroll
        for (int sj = 0; sj < 16; ++sj) { const int s = sj >> 3, j = sj & 7, slot = 16 * s + 8 * hi + j, q = QB * 32 + attn_body::qperm(slot);
            const unsigned word = F.MASK[(size_t)(b * T + q) * 128 + KB]; const unsigned byte = ((word >> key) & 1u) ? 0x00u : 0xE4u;
            w[sj >> 2] |= byte << (8 * (sj & 3)); }
        v4u o; o.x = w[0]; o.y = w[1]; o.z = w[2]; o.w = w[3];
        *(v4u*)(F.MASKB + ((size_t)(b * 128 + QB) * 128 + KB) * 1024 + lane * 16) = o;
    }
}
__device__ __forceinline__ void p7_rows(Frame& F) {
    const int gw = F.vcu * NWAVES + F.wave, NGW = F.G * NWAVES;
    for (int m = gw; m < M; m += NGW) {
        GAS f32x4* xr = (GAS f32x4*)(F.out + (size_t)m * D) + F.lane;
        f32x4 v[4]; float s = 0.f;
#pragma unroll
        for (int j = 0; j < 4; ++j) { v[j] = xr[64 * j]; s += (v[j].x * v[j].x + v[j].y * v[j].y) + (v[j].z * v[j].z + v[j].w * v[j].w); }
        const float inv = 1.f / sqrtf(wave_sum(s) * (1.f / D) + EPS);
#pragma unroll
        for (int j = 0; j < 4; ++j) { const f32x4 g = *(const f32x4*)(F.norm_f + 4 * F.lane + 256 * j); xr[64 * j] = (v[j] * inv) * g; }
    }
}

__global__ void __launch_bounds__(NWAVES * 64, 2) fwd_kernel(Args args) {
    extern __shared__ __attribute__((aligned(16))) unsigned char lds[];
    Frame F;
    F.lds = (LAS unsigned char*)lds;
    F.MISC = (volatile LAS unsigned*)(F.lds + MISC_OFF);
    F.tid = threadIdx.x; F.lane = F.tid & 63; F.wave = __builtin_amdgcn_readfirstlane(F.tid >> 6);
    F.G = gridDim.x; { const int bx = blockIdx.x; F.vcu = (F.G % 8 == 0) ? (bx % 8) * (F.G / 8) + bx / 8 : bx; }
    unsigned char* ws = args.ws;
    F.ctl = (gu32*)(ws + WS_CTL);
    F.x = (const float*)args.in[0]; F.c = (const float*)args.in[1]; F.positions = (const int*)args.in[2]; F.w_ada = (const float*)args.in[3]; F.b_ada = (const float*)args.in[4];
    F.norm_in = (const float*)args.in[5]; F.w_in = (const float*)args.in[6]; F.conv_w = (const float*)args.in[7]; F.conv_b = (const float*)args.in[8];
    F.gn_conv = (const float*)args.in[9]; F.gn_attn = (const float*)args.in[10]; F.w_out = (const float*)args.in[11]; F.norm_f = (const float*)args.in[12];
    F.out = args.out;
    F.MOD = (float*)(ws + WS_CTL) + CW_MOD; F.ROPE = (float*)(ws + WS_ROPE); F.IW = (float*)(ws + WS_IW);
    F.WIN = (u16*)(ws + WS_WIN); F.WOUT = (u16*)(ws + WS_WOUT); F.H = (u16*)(ws + WS_H); F.CONV = (u16*)(ws + WS_CONV); F.ATT = (u16*)(ws + WS_ATT); F.IDX = (u16*)(ws + WS_IDX); F.YCAT = (u16*)(ws + WS_YCAT); F.MASK = (unsigned*)(ws + WS_MASK); F.MASKB = ws + WS_MASKB;
    for (int u = F.tid; u < (LDS_BYTES - LDSCTL_OFF) / 4; u += NWAVES * 64) ((LAS unsigned*)(F.lds + LDSCTL_OFF))[u] = 0u;
    __syncthreads();
    XcdBarrier bar; bar.bar = (unsigned*)(F.ctl + CW_BAR); bar.x = 0; bar.st = nullptr;
    if (N_LAUNCHES != PER_PHASE) bar = xcd_barrier_post((unsigned*)(F.ctl + CW_BAR), F.MISC + 8);
#define GRID_BAR(seam) do { if (N_LAUNCHES == PER_PHASE) { if (F.tid == 0) __hip_atomic_store(F.ctl + CW_TMO, 0xBADBA0u | (unsigned)(seam), RLX_AGENT); } else { xcd_barrier(bar); } } while (0)
    const int lo = args.ph_lo, hi = args.ph_hi;
#define IN(k) (lo <= (k) && (k) < hi)
#define BOTH(k) (IN(k) && IN((k) + 1))
    if (IN(0)) { p0_prologue(F, args); if (BOTH(0)) GRID_BAR(0); }
    if (IN(1)) { p1_rows(F); if (BOTH(1)) GRID_BAR(1); }
    if (IN(2)) {
        pg8::Gemm g{F.H, F.WIN, M, NPROJ, D}; pg8::StaticOrder S; S.init(M, NPROJ, F.G, (int)blockIdx.x);
        pg8::EpiProj E{F.CONV, (size_t)(WS_ATT - WS_CONV) / 2, F.IW, C2, IWSCALE};
        static_assert(WS_IDX - WS_ATT == WS_ATT - WS_CONV, "EpiProj: evenly spaced output arrays");
        pg8::gemm_phase<pg8::EpiProj, pg8::StaticOrder, true, true, true>(F.lds + RING_OFF, g, S, E);
        if (BOTH(2)) GRID_BAR(2);
    }
    if (IN(3)) { p3_rows(F); if (BOTH(3)) GRID_BAR(3); }
    if (IN(4)) { p4_indexer(F); if (BOTH(4)) GRID_BAR(4); }
    if (IN(5)) { p5_convert(F); if (BOTH(5)) GRID_BAR(5); }
#if defined(BASELINE_ATTN)
    if (IN(6)) { p5_attn(F); if (BOTH(6)) GRID_BAR(6); }
#else
    if (IN(6)) {
        const attn_body::AttnTensors AT{(const attn_body::bf16*)F.ATT, (const attn_body::bf16*)(F.ATT + 512), (const attn_body::bf16*)(F.ATT + 1024), F.MASKB, (const attn_body::bf16*)(F.ATT + 1536), F.gn_attn, F.YCAT};
        const attn_body::StaticOrder S((int)F.G, (int)blockIdx.x);
        attn_body::attn_phase<attn_body::StaticOrder>((char*)lds + RING_OFF, AT, S);
        if (BOTH(6)) GRID_BAR(6);
    }
#endif
    if (IN(7)) {
        pg8::Gemm g{F.YCAT, F.WOUT, M, D, D}; pg8::StaticOrder S; S.init(M, D, F.G, (int)blockIdx.x);
        pg8::EpiOut E{F.x, F.out, D, F.MOD + 2 * D, 3 * D, T};
        pg8::gemm_phase<pg8::EpiOut, pg8::StaticOrder, false, true, true>(F.lds + RING_OFF, g, S, E);
        if (BOTH(7)) GRID_BAR(7);
    }
    if (IN(8)) { p7_rows(F); }
#undef IN
#undef BOTH
}

extern "C" void kernel_launch(void* const* d_in, const int* in_sizes, int n_in, void* d_out, int out_size, void* d_ws, size_t ws_size, hipStream_t stream) {
    static int grid = 0;
    if (grid == 0) {
        if (n_in != 13 || in_sizes[0] != M * D || out_size != M * D || ws_size < WS_END) { fprintf(stderr, "kernel_launch: unexpected shapes (n_in %d, in0 %d, out %d, ws %zu); nothing launched\n", n_in, n_in > 0 ? in_sizes[0] : -1, out_size, ws_size); grid = -1; return; }
        int dev = 0, cus = 0, per_cu = 0;
        if (hipGetDevice(&dev) != hipSuccess || hipDeviceGetAttribute(&cus, hipDeviceAttributeMultiprocessorCount, dev) != hipSuccess) { grid = -1; return; }
        if (hipFuncSetAttribute((const void*)fwd_kernel, hipFuncAttributeMaxDynamicSharedMemorySize, LDS_BYTES) != hipSuccess) { fprintf(stderr, "kernel_launch: hipFuncSetAttribute failed\n"); grid = -1; return; }
        if (hipOccupancyMaxActiveBlocksPerMultiprocessor(&per_cu, (const void*)fwd_kernel, NWAVES * 64, LDS_BYTES) != hipSuccess || per_cu < 1)
            fprintf(stderr, "kernel_launch: note: occupancy query reports %d workgroups per CU\n", per_cu);
        (void)hipGetLastError();
        grid = cus;
    }
    if (grid < 0) return;
    if (hipMemsetAsync((char*)d_ws + WS_CTL, 0, CTL_ZERO_BYTES, stream) != hipSuccess) return;
    Args a{};
    for (int i = 0; i < 13; ++i) a.in[i] = d_in[i];
    a.out = (float*)d_out; a.ws = (unsigned char*)d_ws;
    { float f[8]; for (int i = 0; i < 8; ++i) f[i] = (float)pow(500000.0, -(double)i / 8.0); a.if0 = f[0]; a.if1 = f[1]; a.if2 = f[2]; a.if3 = f[3]; a.if4 = f[4]; a.if5 = f[5]; a.if6 = f[6]; a.if7 = f[7]; }
    for (int li = 0; li < N_LAUNCHES; ++li) {
        a.ph_lo = (N_LAUNCHES == PER_PHASE) ? li : 0; a.ph_hi = (N_LAUNCHES == PER_PHASE) ? li + 1 : PER_PHASE;
        hipLaunchKernelGGL(fwd_kernel, dim3(grid), dim3(NWAVES * 64), LDS_BYTES, stream, a);
        const hipError_t le = hipPeekAtLastError();
        if (le != hipSuccess) { fprintf(stderr, "kernel_launch: launch %d failed: %s\n", li, hipGetErrorName(le)); break; }
    }
}
```

```cpp
#include <hip/hip_runtime.h>
#include <cstdio>
#include <cstdint>
#include <cmath>
namespace pg8 {
#define PG8_LAS __attribute__((address_space(3)))
typedef unsigned short bf16_t;
typedef short bf16x8 __attribute__((ext_vector_type(8)));
typedef float f32x4 __attribute__((ext_vector_type(4)));
typedef unsigned u32x4 __attribute__((ext_vector_type(4)));
constexpr int BM = 256, BK = 64, HALF = 128, HTB = HALF * BK * 2  , STAGE_BYTES = 8 * HTB, NXCD = 8, WGM = 8;

__host__ __device__ __forceinline__ int lds_byte(int r, int c) { const int st = (r >> 4) * 2 + (c >> 5), rr = r & 15, cc = c & 31, ob = rr * 64 + cc * 2; return st * 1024 + (ob ^ (((ob >> 9) & 1) << 5)); }
__host__ __device__ __forceinline__ void stage_rc(int b, int& R, int& C) { const int st = b / 1024, sb = b % 1024, swz = sb ^ (((sb >> 9) & 1) << 5); R = (st >> 1) * 16 + swz / 64; C = (st & 1) * 32 + (swz % 64) / 2; }
__host__ __device__ __forceinline__ int perm32(int rho) { const int n = rho >> 4, i = rho & 15; return 8 * (i >> 2) + 4 * n + (i & 3); }

struct Unit { int pm, pn; };
struct Gemm { const bf16_t* A; const bf16_t* Bt; int M, N, K; };

struct StaticOrder {
    int nM, nN, nwg, G, c;
    __host__ __device__ void init(int M, int N, int G_, int c_) { nM = M / BM; nN = N / BM; nwg = nM * nN; G = G_; c = c_; }
    __host__ __device__ bool next(int i, Unit& u) const {
        const long L = (long)i * G + c; if (L >= nwg) return false;
        int wgid = (int)L; { const int q = nwg / NXCD, r = nwg % NXCD, xcd = wgid % NXCD, off = wgid / NXCD; wgid = (xcd < r ? xcd * (q + 1) : r * (q + 1) + (xcd - r) * q) + off; }
        const int nig = WGM * nN, gid = wgid / nig, fm = gid * WGM, gsz = (nM - fm) < WGM ? (nM - fm) : WGM;
        u.pm = fm + ((wgid % nig) % gsz); u.pn = (wgid % nig) / gsz; return true;
    }
    __device__ __forceinline__ void a_ready(const Unit&) const {}
    __device__ __forceinline__ void done(const Unit&) const {}
};

__device__ __forceinline__ unsigned cvt_pk_bf16(float lo, float hi) { unsigned r; asm volatile("v_cvt_pk_bf16_f32 %0, %1, %2" : "=v"(r) : "v"(lo), "v"(hi)); return r; }
typedef float f32x2 __attribute__((ext_vector_type(2)));
typedef _Float16 f16x8 __attribute__((ext_vector_type(8)));
typedef _Float16 f16x2 __attribute__((ext_vector_type(2)));
__device__ __forceinline__ unsigned cvt_pk_f16(float lo, float hi) { f16x2 v = {(_Float16)lo, (_Float16)hi}; return __builtin_bit_cast(unsigned, v); }
template <bool F16> __device__ __forceinline__ f32x4 mma16(bf16x8 a, bf16x8 b, f32x4 c) {
    if constexpr (F16) return __builtin_amdgcn_mfma_f32_16x16x32_f16(__builtin_bit_cast(f16x8, a), __builtin_bit_cast(f16x8, b), c, 0, 0, 0);
    else return __builtin_amdgcn_mfma_f32_16x16x32_bf16(a, b, c, 0, 0, 0);
}

struct EpiProj {
    static constexpr bool PERM = true, AFTER_DRAIN = false;
    bf16_t* CONV; size_t gstride; float* IW; float qscale, iwscale;
    __device__ __forceinline__ void operator()(const f32x4 (&acc)[2][2][4][2], const Unit& u, int wr, int wc, int fr, int fq) const {
        const int grp = u.pn >> 3; bf16_t* O = CONV + (size_t)grp * gstride; const int ldc = grp == 2 ? 768 : 2048;
        const int row0 = u.pm * BM + wr * 64 + fr; const int col0 = (u.pn & 7) * BM + wc * 32 + 8 * fq;
        const float sc = (u.pn == 8 || u.pn == 9) ? qscale : 1.f; const bool h16 = u.pn >= 16;
#pragma unroll
        for (int ai = 0; ai < 2; ++ai)
#pragma unroll
            for (int m = 0; m < 4; ++m) { const int row = row0 + ai * HALF + m * 16; bf16_t* rowp = O + (size_t)row * ldc + col0;
#pragma unroll
                for (int bj = 0; bj < 2; ++bj) { const f32x4 v0 = acc[ai][bj][m][0] * sc, v1 = acc[ai][bj][m][1] * sc; u32x4 w;
                    if (h16) { w.x = cvt_pk_f16(v0[0], v0[1]); w.y = cvt_pk_f16(v0[2], v0[3]); w.z = cvt_pk_f16(v1[0], v1[1]); w.w = cvt_pk_f16(v1[2], v1[3]); }
                    else { w.x = cvt_pk_bf16(v0[0], v0[1]); w.y = cvt_pk_bf16(v0[2], v0[3]); w.z = cvt_pk_bf16(v1[0], v1[1]); w.w = cvt_pk_bf16(v1[2], v1[3]); }
                    *(u32x4*)(rowp + bj * HALF) = w;
                    if (bj == 0 && u.pn == 18 && wc == 2 && fq == 0) { float* ip = IW + (size_t)row * 8; *(f32x4*)ip = v0 * iwscale; *(f32x4*)(ip + 4) = v1 * iwscale; } } }
    }
};
struct EpiOut {
    static constexpr bool PERM = false, AFTER_DRAIN = false;
    const float* x; float* out; int ldc; const float* gate; int gstride; int rows_per_batch;
    __device__ __forceinline__ void operator()(const f32x4 (&acc)[2][2][4][2], const Unit& u, int wr, int wc, int fr, int fq) const {
        const int row0 = u.pm * BM + wr * 64 + fr; const int col0 = u.pn * BM + wc * 32 + 4 * fq;
        const float* g = gate + (size_t)((u.pm * BM) / rows_per_batch) * gstride;
        f32x4 gv[2][2];
#pragma unroll
        for (int bj = 0; bj < 2; ++bj)
#pragma unroll
            for (int n = 0; n < 2; ++n) gv[bj][n] = *(const f32x4*)(g + col0 + bj * HALF + n * 16);
#pragma unroll
        for (int ai = 0; ai < 2; ++ai)
#pragma unroll
            for (int m = 0; m < 4; ++m) { const size_t off = (size_t)(row0 + ai * HALF + m * 16) * ldc + col0;
#pragma unroll
                for (int bj = 0; bj < 2; ++bj)
#pragma unroll
                    for (int n = 0; n < 2; ++n) { const f32x4 xv = *(const f32x4*)(x + off + bj * HALF + n * 16);
                        *(f32x4*)(out + off + bj * HALF + n * 16) = xv + gv[bj][n] * acc[ai][bj][m][n]; } }
    }
};

template <class Epi, class Sched, bool ALIGN_EPI = false, bool SP2 = false, bool F16 = false>
__device__ __forceinline__ void gemm_phase(PG8_LAS unsigned char* lds, const Gemm g, const Sched& S, const Epi& E) {
    const int tid = threadIdx.x, wid = __builtin_amdgcn_readfirstlane(tid >> 6), lane = tid & 63, wr = wid >> 2, wc = wid & 3, fr = lane & 15, fq = lane >> 4;
    const int K = g.K, nt = K / BK;
    unsigned voffA[2], voffB[2];
#pragma unroll
    for (int i = 0; i < 2; ++i) { int R, C; stage_rc(tid * 16 + i * 8192, R, C); const int Rb = Epi::PERM ? ((R & ~31) + perm32(R & 31)) : R;
        voffA[i] = (unsigned)(R * K + C) * 2u; voffB[i] = (unsigned)(Rb * K + C) * 2u; }
    const size_t kstep = (size_t)(BK * 2);
    const size_t hstep = (size_t)HALF * K * 2;
    const size_t tstep = 2 * hstep;
    const unsigned ldsw = (unsigned)wid * 1024u;
    const int aoff = lds_byte(wr * 64 + fr, fq * 8), boff = lds_byte(wc * 32 + fr, fq * 8);
#define PG8_SA(b, h) (((b) * 2 + (h)) * HTB)
#define PG8_SB(b, h) ((4 + (b) * 2 + (h)) * HTB)
#define PG8_STAGE(bufoff, gbase, voff) do { _Pragma("unroll") for (int _i = 0; _i < 2; ++_i) \
        __builtin_amdgcn_global_load_lds((const unsigned*)((const char*)(gbase) + (voff)[_i]), (PG8_LAS unsigned*)(lds + (bufoff) + ldsw + _i * 8192), 16, 0, 0); } while (0)
#define PG8_LDA(dst, b, h) do { _Pragma("unroll") for (int m = 0; m < 4; ++m) _Pragma("unroll") for (int k = 0; k < 2; ++k) dst[m][k] = *(const PG8_LAS bf16x8*)(lds + PG8_SA(b, h) + aoff + m * 2048 + k * 1024); } while (0)
#define PG8_LDB(dst, b, h) do { _Pragma("unroll") for (int n = 0; n < 2; ++n) _Pragma("unroll") for (int k = 0; k < 2; ++k) dst[n][k] = *(const PG8_LAS bf16x8*)(lds + PG8_SB(b, h) + boff + n * 2048 + k * 1024); } while (0)
#define PG8_MMA(ai, bj, At, Bt) do { __builtin_amdgcn_s_setprio(1); _Pragma("unroll") for (int m = 0; m < 4; ++m) _Pragma("unroll") for (int n = 0; n < 2; ++n) _Pragma("unroll") for (int k = 0; k < 2; ++k) \
        acc[ai][bj][m][n] = mma16<F16>(Bt[n][k], At[m][k], acc[ai][bj][m][n]); __builtin_amdgcn_s_setprio(0); } while (0)
#define PG8_WAIT_V(n) asm volatile("s_waitcnt vmcnt(" #n ")" ::: "memory")
#define PG8_WAIT_L(n) asm volatile("s_waitcnt lgkmcnt(" #n ")" ::: "memory")
#define PG8_BAR __builtin_amdgcn_s_barrier()
#define PG8_SCHED __builtin_amdgcn_sched_barrier(0)
    Unit cur, nxt; int ui = 0;
    if (!S.next(0, cur)) return;
    f32x4 acc[2][2][4][2];
#pragma unroll
    for (int a = 0; a < 2; ++a)
#pragma unroll
        for (int b = 0; b < 2; ++b)
#pragma unroll
            for (int m = 0; m < 4; ++m)
#pragma unroll
                for (int n = 0; n < 2; ++n) acc[a][b][m][n] = (f32x4){0.f, 0.f, 0.f, 0.f};
    bf16x8 At[4][2], B0[2][2], B1[2][2];
    const char* cA = (const char*)g.A + (size_t)cur.pm * tstep; const char* cB = (const char*)g.Bt + (size_t)cur.pn * tstep;
    S.a_ready(cur);
    if constexpr (SP2) {
        PG8_STAGE(PG8_SB(0, 0), cB, voffB); PG8_STAGE(PG8_SB(0, 1), cB + hstep, voffB); PG8_STAGE(PG8_SA(0, 0), cA, voffA); PG8_STAGE(PG8_SA(0, 1), cA + hstep, voffA);
        if (wr == 1) PG8_BAR;
        PG8_WAIT_V(2); PG8_BAR;
        PG8_STAGE(PG8_SB(1, 0), cB + kstep, voffB); PG8_STAGE(PG8_SA(1, 0), cA + kstep, voffA); PG8_STAGE(PG8_SB(1, 1), cB + hstep + kstep, voffB);
        PG8_WAIT_V(6); PG8_BAR;
    } else {
        PG8_STAGE(PG8_SB(0, 0), cB, voffB); PG8_STAGE(PG8_SA(0, 0), cA, voffA); PG8_STAGE(PG8_SB(0, 1), cB + hstep, voffB); PG8_STAGE(PG8_SA(0, 1), cA + hstep, voffA);
        if (wr == 1) PG8_BAR;
        PG8_WAIT_V(4); PG8_BAR;
        PG8_STAGE(PG8_SB(1, 0), cB + kstep, voffB); PG8_STAGE(PG8_SA(1, 0), cA + kstep, voffA); PG8_STAGE(PG8_SB(1, 1), cB + hstep + kstep, voffB);
        PG8_WAIT_V(6); PG8_BAR;
    }
    for (;;) {
        const bool has_next = S.next(ui + 1, nxt);
        const char* nA = has_next ? (const char*)g.A + (size_t)nxt.pm * tstep : cA; const char* nB = has_next ? (const char*)g.Bt + (size_t)nxt.pn * tstep : cB;
        for (int t = 0; t < nt; t += 2) {
            const bool last = (t == nt - 2);
            const char* a1 = cA + (size_t)(t + 1) * kstep;
            const char* a2 = last ? nA : cA + (size_t)(t + 2) * kstep; const char* b2 = last ? nB : cB + (size_t)(t + 2) * kstep;
            const char* a3 = a2 + kstep; const char* b3 = b2 + kstep;
            if (last && has_next) S.a_ready(nxt);
            if constexpr (SP2) {
            PG8_LDB(B0, 0, 0); PG8_LDB(B1, 0, 1); PG8_SCHED; PG8_LDA(At, 0, 0); PG8_STAGE(PG8_SA(1, 1), a1 + hstep, voffA);
            PG8_WAIT_V(8); PG8_WAIT_L(0); PG8_BAR; PG8_MMA(0, 0, At, B0); PG8_MMA(0, 1, At, B1); PG8_BAR; PG8_SCHED;
            PG8_LDA(At, 0, 1); PG8_STAGE(PG8_SB(0, 0), b2, voffB); PG8_STAGE(PG8_SB(0, 1), b2 + hstep, voffB); PG8_STAGE(PG8_SA(0, 0), a2, voffA);
            PG8_WAIT_V(8); PG8_WAIT_L(0); PG8_BAR; PG8_MMA(1, 0, At, B0); PG8_MMA(1, 1, At, B1); PG8_BAR; PG8_SCHED;
            PG8_LDB(B0, 1, 0); PG8_LDB(B1, 1, 1); PG8_SCHED; PG8_LDA(At, 1, 0); PG8_STAGE(PG8_SA(0, 1), a2 + hstep, voffA);
            PG8_WAIT_V(8); PG8_WAIT_L(0); PG8_BAR; PG8_MMA(0, 0, At, B0); PG8_MMA(0, 1, At, B1); PG8_BAR; PG8_SCHED;
            PG8_LDA(At, 1, 1); PG8_STAGE(PG8_SB(1, 0), b3, voffB); PG8_STAGE(PG8_SB(1, 1), b3 + hstep, voffB); PG8_STAGE(PG8_SA(1, 0), a3, voffA);
            PG8_WAIT_V(8); PG8_WAIT_L(0); PG8_BAR; PG8_MMA(1, 0, At, B0); PG8_MMA(1, 1, At, B1); PG8_BAR; PG8_SCHED;
            } else {
            PG8_LDB(B0, 0, 0); PG8_SCHED; PG8_LDA(At, 0, 0); PG8_STAGE(PG8_SA(1, 1), a1 + hstep, voffA);
            PG8_WAIT_L(8); PG8_BAR; PG8_WAIT_L(0); PG8_MMA(0, 0, At, B0); PG8_BAR; PG8_SCHED;
            PG8_LDB(B1, 0, 1); PG8_STAGE(PG8_SB(0, 0), b2, voffB);
            PG8_BAR; PG8_WAIT_L(0); PG8_MMA(0, 1, At, B1); PG8_BAR;
            PG8_LDA(At, 0, 1); PG8_STAGE(PG8_SA(0, 0), a2, voffA);
            PG8_BAR; PG8_WAIT_L(0); PG8_MMA(1, 0, At, B0); PG8_BAR; PG8_SCHED;
            PG8_STAGE(PG8_SB(0, 1), b2 + hstep, voffB);
            PG8_WAIT_V(6); PG8_BAR; PG8_MMA(1, 1, At, B1); PG8_BAR;
            PG8_LDB(B0, 1, 0); PG8_SCHED; PG8_LDA(At, 1, 0); PG8_STAGE(PG8_SA(0, 1), a2 + hstep, voffA);
            PG8_WAIT_L(8); PG8_BAR; PG8_WAIT_L(0); PG8_MMA(0, 0, At, B0); PG8_BAR; PG8_SCHED;
            PG8_LDB(B1, 1, 1); PG8_STAGE(PG8_SB(1, 0), b3, voffB);
            PG8_BAR; PG8_WAIT_L(0); PG8_MMA(0, 1, At, B1); PG8_BAR;
            PG8_LDA(At, 1, 1); PG8_STAGE(PG8_SA(1, 0), a3, voffA);
            PG8_BAR; PG8_WAIT_L(0); PG8_MMA(1, 0, At, B0); PG8_BAR; PG8_SCHED;
            PG8_STAGE(PG8_SB(1, 1), b3 + hstep, voffB);
            PG8_WAIT_V(6); PG8_BAR; PG8_MMA(1, 1, At, B1); PG8_BAR;
            }
        }
        if constexpr (ALIGN_EPI) { if (wr == 0) PG8_BAR; }
        if constexpr (!Epi::AFTER_DRAIN) { E(acc, cur, wr, wc, fr, fq); S.done(cur); }
        if (!has_next) break;
#pragma unroll
        for (int a = 0; a < 2; ++a)
#pragma unroll
            for (int b = 0; b < 2; ++b)
#pragma unroll
                for (int m = 0; m < 4; ++m)
#pragma unroll
                    for (int n = 0; n < 2; ++n) acc[a][b][m][n] = (f32x4){0.f, 0.f, 0.f, 0.f};
        cur = nxt; cA = nA; cB = nB; ++ui;
        if constexpr (ALIGN_EPI) { if (wr == 1) PG8_BAR; }
    }
    PG8_WAIT_V(0);
    if constexpr (!ALIGN_EPI) { if (wr == 0) PG8_BAR; }
    PG8_BAR;
    if constexpr (Epi::AFTER_DRAIN) { E.fused(acc, cur, wr, wc, fr, fq, lds, wid, lane); S.done(cur); }
#undef PG8_SA
#undef PG8_SB
#undef PG8_STAGE
#undef PG8_LDA
#undef PG8_LDB
#undef PG8_MMA
#undef PG8_WAIT_V
#undef PG8_WAIT_L
#undef PG8_BAR
#undef PG8_SCHED
}
}

#include <hip/hip_bf16.h>
#include <cmath>
namespace attn_body {
using bf16=__hip_bfloat16;
using bf16x8=__attribute__((ext_vector_type(8)))short;
using s16x4=__attribute__((ext_vector_type(4)))short;
using f32x16=__attribute__((ext_vector_type(16)))float;
using u32x4=__attribute__((ext_vector_type(4)))unsigned;
constexpr int BATCH=4,NHEAD=8,SEQ=4096,D=64,DM=2048;
constexpr int NW=8,QBLK=32,QB=QBLK*NW,KVBLK=64,NQB=SEQ/QB;
constexpr int ATTN_PITCH=DM, ATTN_UNIT_ROWS=QB;
__device__ __forceinline__ int crow(int r,int hi){return (r&3)+8*(r>>2)+4*hi;}
#define SBAR() __builtin_amdgcn_sched_barrier(0)
__device__ __forceinline__ void cmask(f32x16&p0,f32x16&p1,int jb,int qrel,int hi){
  const float NEG=-INFINITY; int kb=64*jb+4*hi;
  #pragma unroll
  for(int r=0;r<16;++r){int kv=kb+(r&3)+8*(r>>2); if(kv>qrel)p0[r]=NEG; if(kv+32>qrel)p1[r]=NEG;}
}

constexpr int NSLOT=3, SLOTB=8192;
constexpr int LDS_K=0, LDS_V=NSLOT*SLOTB, LDS_WS=2*NSLOT*SLOTB, LDS_OST=LDS_WS+NW*64*4, LDS_BYTES=LDS_OST+NW*4096;
constexpr float C2=0.125f*1.4426950408889634f;
__device__ __forceinline__ void glds16(const void*gsrc,unsigned lds_dst){unsigned keep;
  asm volatile("s_mov_b32 %0, m0\n\ts_mov_b32 m0, %2\n\ts_nop 0\n\tglobal_load_lds_dwordx4 %1, off\n\ts_mov_b32 m0, %0":"=&s"(keep):"v"(gsrc),"s"(lds_dst):"memory");}
__device__ __forceinline__ float max3f(float a,float b,float c){float r;asm("v_max3_f32 %0, %1, %2, %3":"=v"(r):"v"(a),"v"(b),"v"(c));return r;}
__device__ __forceinline__ float max2f(float a,float b){float r;asm("v_max_f32_e32 %0, %1, %2":"=v"(r):"v"(a),"v"(b));return r;}
__device__ __forceinline__ float fadd_s(float a,float b){float r;asm("v_add_f32_e32 %0, %1, %2":"=v"(r):"v"(a),"v"(b));return r;}
__device__ __forceinline__ float fsub_s(float a,float b){float r;asm("v_sub_f32_e32 %0, %1, %2":"=v"(r):"v"(a),"v"(b));return r;}
typedef float f32x2_t __attribute__((ext_vector_type(2))); typedef __bf16 bf16x2_t __attribute__((ext_vector_type(2)));
__device__ __forceinline__ unsigned cvtpk_s(float lo,float hi){f32x2_t v={lo,hi};bf16x2_t b=__builtin_convertvector(v,bf16x2_t);return __builtin_bit_cast(unsigned,b);}
#define WAIT_BAR(N) asm volatile("s_waitcnt vmcnt(" #N ") lgkmcnt(0)\n\ts_barrier":::"memory")

__device__ __forceinline__ void qkt(f32x16&p0,f32x16&p1,const char*Kslot,const bf16x8*qr,const f32x16&i0,const f32x16&i1,int r32,int hi){
  const char*kb=Kslot+hi*1024+r32*16;
  #pragma unroll
  for(int d0=0;d0<4;++d0){
    const bf16x8 b0=*reinterpret_cast<const bf16x8*>(kb+d0*2048);
    const bf16x8 b1=*reinterpret_cast<const bf16x8*>(kb+d0*2048+512);
    if(d0==0){p0=__builtin_amdgcn_mfma_f32_32x32x16_bf16(b0,qr[0],i0,0,0,0);p1=__builtin_amdgcn_mfma_f32_32x32x16_bf16(b1,qr[0],i1,0,0,0);}
    else{p0=__builtin_amdgcn_mfma_f32_32x32x16_bf16(b0,qr[d0],p0,0,0,0);p1=__builtin_amdgcn_mfma_f32_32x32x16_bf16(b1,qr[d0],p1,0,0,0);}}
}
typedef __attribute__((address_space(3))) const char* lds_cptr;
typedef short v4i16_t __attribute__((ext_vector_type(4)));
__device__ __forceinline__ void kload8(bf16x8*kf,lds_cptr kp){
  kf[0]=*(const __attribute__((address_space(3))) bf16x8*)(kp);      kf[1]=*(const __attribute__((address_space(3))) bf16x8*)(kp+512);
  kf[2]=*(const __attribute__((address_space(3))) bf16x8*)(kp+2048); kf[3]=*(const __attribute__((address_space(3))) bf16x8*)(kp+2560);
  kf[4]=*(const __attribute__((address_space(3))) bf16x8*)(kp+4096); kf[5]=*(const __attribute__((address_space(3))) bf16x8*)(kp+4608);
  kf[6]=*(const __attribute__((address_space(3))) bf16x8*)(kp+6144); kf[7]=*(const __attribute__((address_space(3))) bf16x8*)(kp+6656);
}
__device__ __forceinline__ void kload2(bf16x8*kf,lds_cptr kp,int j){ kf[2*j]=*(const __attribute__((address_space(3))) bf16x8*)(kp+j*2048); kf[2*j+1]=*(const __attribute__((address_space(3))) bf16x8*)(kp+j*2048+512); }
__device__ __forceinline__ s16x4 vtr(lds_cptr p){ return __builtin_bit_cast(s16x4,__builtin_amdgcn_ds_read_tr16_b64_v4i16((__attribute__((address_space(3))) v4i16_t*)p)); }
__device__ __forceinline__ float rowmax(const f32x16&p0,const f32x16&p1){
  float a=max3f(p0[0],p0[1],p1[0]),b=max3f(p0[2],p0[3],p1[1]);a=max3f(a,p1[2],p1[3]);
  #pragma unroll
  for(int r=4;r<16;r+=4){a=max3f(a,p0[r],p0[r+1]);b=max3f(b,p0[r+2],p0[r+3]);a=max3f(a,p1[r],p1[r+1]);b=max3f(b,p1[r+2],p1[r+3]);}
  const float m=max2f(a,b);
  auto rr=__builtin_amdgcn_permlane32_swap(__float_as_uint(m),__float_as_uint(m),false,false);
  return max2f(__uint_as_float(rr[0]),__uint_as_float(rr[1]));
}
__device__ __forceinline__ void pv(f32x16*o,int vb,bf16x8 pa0,bf16x8 pa1,bf16x8 pa2,bf16x8 pa3){
  #pragma unroll
  for(int d0=0;d0<2;++d0){s16x4 lo[4],hi[4];
    #pragma unroll
    for(int ks=0;ks<4;++ks){
      asm volatile("ds_read_b64_tr_b16 %0,%1 offset:%c2":"=&v"(lo[ks]):"v"(vb),"i"(d0*4096+ks*1024):"memory");
      asm volatile("ds_read_b64_tr_b16 %0,%1 offset:%c2":"=&v"(hi[ks]):"v"(vb),"i"(d0*4096+ks*1024+512):"memory");}
    asm volatile("s_waitcnt lgkmcnt(0)":::"memory");SBAR();
    #define PK(k) (bf16x8){lo[k][0],lo[k][1],lo[k][2],lo[k][3],hi[k][0],hi[k][1],hi[k][2],hi[k][3]}
    o[d0]=__builtin_amdgcn_mfma_f32_32x32x16_bf16(pa0,PK(0),o[d0],0,0,0);
    o[d0]=__builtin_amdgcn_mfma_f32_32x32x16_bf16(pa1,PK(1),o[d0],0,0,0);
    o[d0]=__builtin_amdgcn_mfma_f32_32x32x16_bf16(pa2,PK(2),o[d0],0,0,0);
    o[d0]=__builtin_amdgcn_mfma_f32_32x32x16_bf16(pa3,PK(3),o[d0],0,0,0);
    #undef PK
  }
}

#ifndef ATTN_STORE16
#define ATTN_STORE16(p,v) (*(u32x4*)(p)=(v))
#endif
typedef long l64x2 __attribute__((ext_vector_type(2)));
#define MFMA8(a,b,c) __builtin_amdgcn_mfma_f32_32x32x16_bf8_bf8((a),(b),(c),0,0,0)
#define MLOAD(dst,ptr,OFF) asm volatile("global_load_dwordx4 %0, %1, off offset:" #OFF : "=v"(dst) : "v"(ptr) : "memory")
#define PIN2(a,b) asm volatile("" : "+v"(a), "+v"(b))
__device__ __forceinline__ int qperm(int s){ return 16*(s>>4)+4*((s&7)>>1)+2*((s>>3)&1)+(s&1); }
template<int THRL> __device__ __forceinline__ void attn_unit(int b,int h,int qb,const bf16*Q,const bf16*__restrict__ K,const bf16*__restrict__ V,const unsigned char*__restrict__ MB,const bf16*__restrict__ AZ,const float*__restrict__ gn,unsigned short*Y,char*shm){
  const int tid=threadIdx.x,lane=tid&63,r32=lane&31,hi=lane>>5; const int wid=__builtin_amdgcn_readfirstlane(tid>>6);
  const long rowbase=(long)b*SEQ; const int q0=qb*QB;
  const bf16*Qw=Q+(rowbase+q0+wid*QBLK)*DM+h*D;
  const bf16*Kh=K+rowbase*DM+h*D,*Vh=V+rowbase*DM+h*D;
  const unsigned lds0=(unsigned)(uintptr_t)shm;
  float*wsf=(float*)(shm+LDS_WS)+wid*64;
  const bf16*ksrc=Kh+(long)lane*DM+wid*8;
  const bf16*vsrc=Vh+(long)(16*(wid&3)+(lane>>2))*DM+(wid>>2)*32+(lane&3)*8;
  const unsigned kdst=lds0+LDS_K+wid*1024, vdst=lds0+LDS_V+wid*1024;
  #define DMA_K(t,slot) glds16(ksrc+(long)(t)*KVBLK*DM,(unsigned)__builtin_amdgcn_readfirstlane(kdst+(slot)))
  #define DMA_V(t,slot) glds16(vsrc+(long)(t)*KVBLK*DM,(unsigned)__builtin_amdgcn_readfirstlane(vdst+(slot)))
  const int vb0=(int)(lds0+LDS_V)+((lane>>4)&1)*32+(lane&3)*8+(4*hi+((lane&15)>>2))*64;
  const char*Kbase=shm+LDS_K; bf16x8 kf[8];
  const lds_cptr shm3=(lds_cptr)shm; const lds_cptr kp0=shm3+LDS_K+hi*1024+r32*16; const lds_cptr vp0=shm3+LDS_V+((lane>>4)&1)*32+(lane&3)*8+(4*hi+((lane&15)>>2))*64;
  const int NT=(q0+QB)/KVBLK;
  const unsigned char*mp=MB+(((size_t)b*128+(size_t)((q0>>5)+wid))*128)*1024+lane*16;
  u32x4 mkA0,mkA1,mkB0,mkB1;
  const long idv_=(((r32>>3)&1)==hi)?(long)(0x3CULL<<(8*(r32&7))):0L; const long id0=((r32>>4)==0)?idv_:0L, id1=((r32>>4)==1)?idv_:0L;
  MLOAD(mkA0,mp,0);MLOAD(mkA1,mp,1024);
  DMA_K(0,0);DMA_V(0,0);DMA_K(1,SLOTB);
  bf16x8 qr[4];
  #pragma unroll
  for(int d0=0;d0<4;++d0)qr[d0]=*reinterpret_cast<const bf16x8*>(&Qw[(long)qperm(r32)*DM+d0*16+hi*8]);
  float mhat=0.f,l_reg=0.f;f32x16 o[2];o[0]=f32x16{};o[1]=f32x16{};f32x16 negm; { float z_; asm volatile("v_mov_b32 %0, 0":"=v"(z_)); _Pragma("unroll") for(int r=0;r<16;++r)negm[r]=z_; } asm volatile("":"+v"(negm));
  const int qrel=wid*QBLK+r32;
  #define CMASK(P0,P1,t) do{}while(0)
  bool resc=false;
  #define START(P0,P1) do{ const float rm=rowmax(P0,P1); resc=false; \
    { const float dl=rm; mhat=fadd_s(mhat,dl); \
      _Pragma("unroll") for(int r=0;r<16;++r){P0[r]=fsub_s(P0[r],dl);P1[r]=fsub_s(P1[r],dl);} \
      _Pragma("unroll") for(int r=0;r<16;++r)negm[r]=-mhat; asm volatile("":"+v"(negm)); } \
    _Pragma("unroll") for(int r=0;r<16;++r)P0[r]=__builtin_amdgcn_exp2f(P0[r]); }while(0)
  #define RESC() do{ if(resc){ asm volatile("s_waitcnt lgkmcnt(0)":::"memory"); \
      _Pragma("unroll") for(int d_=0;d_<2;++d_) _Pragma("unroll") for(int r=0;r<16;++r)o[d_][r]*=wsf[crow(r,hi)]; } }while(0)
  f32x16 pA0,pA1,pB0,pB1;
  int sl_prev=0,sl_cur=0,sl_next=SLOTB;
  #define ROT() do{sl_prev=sl_cur;sl_cur=sl_next;sl_next=(sl_next==(NSLOT-1)*SLOTB)?0:sl_next+SLOTB;}while(0)
  DMA_K(2,2*SLOTB);
  WAIT_BAR(3);
  PIN2(mkA0,mkA1);
  { const l64x2 m0_=__builtin_bit_cast(l64x2,mkA0), m1_=__builtin_bit_cast(l64x2,mkA1); f32x16 i0_=MFMA8(m0_[0],id0,negm), i1_=MFMA8(m1_[0],id0,negm); i0_=MFMA8(m0_[1],id1,i0_); i1_=MFMA8(m1_[1],id1,i1_);
    qkt(pA0,pA1,Kbase,qr,i0_,i1_,r32,hi); }
  asm volatile("s_nop 15\n\ts_nop 7":"+v"(pA0),"+v"(pA1));
  START(pA0,pA1);
  _Pragma("unroll") for(int r=0;r<16;++r)pA1[r]=__builtin_amdgcn_exp2f(pA1[r]);
  WAIT_BAR(0);
  MLOAD(mkB0,mp+2048,0);MLOAD(mkB1,mp+2048,1024);
  DMA_K(3,0);DMA_V(1,SLOTB);
  ROT();
  kload8(kf,kp0+sl_cur);
  WAIT_BAR(2);
  PIN2(mkB0,mkB1);
  s16x4 vlo[8],vhi[8]; u32x4 pw0,pw1,pw2,pw3;
  #define PKW(P,B) cvtpk_s(P[B],P[B+1])
  #define PAF(k) __builtin_bit_cast(bf16x8,pw##k)
  #define VFR(i) (bf16x8){vlo[i][0],vlo[i][1],vlo[i][2],vlo[i][3],vhi[i][0],vhi[i][1],vhi[i][2],vhi[i][3]}
  #define PIN(x) asm volatile("":"+v"(x))
  #define MX3(a,b,c) __builtin_fmaxf(__builtin_fmaxf((a),(b)),(c))
  #define GAPA(MF,A0,A1,A2,A3,W0,W1,PW) do{ MF; sacc+=A0; sacc+=A1; sacc+=A2; sacc+=A3; PIN(sacc); W0; W1; PIN(PW); SBAR(); }while(0)
  #define EX(v) __builtin_amdgcn_exp2f(v)
  #define GAPB(MF,X,B) do{ MF; X[B]=EX(X[B]); X[B+1]=EX(X[B+1]); X[B+2]=EX(X[B+2]); X[B+3]=EX(X[B+3]); PIN(X); SBAR(); }while(0)
  #define VRD(i) do{ vlo[i]=vtr(vp_+(((i)>>2)*4096+((i)&3)*1024)); vhi[i]=vtr(vp_+(((i)>>2)*4096+((i)&3)*1024+512)); }while(0)
  #define KRD(G,j) do{ if(G){ kload2(kf,kp0+sl_next,j); SBAR(); } }while(0)
  #define STEP(C0,C1,P0,P1,t,GK,GV,GL,MC0,MC1,MN0,MN1) do{ SBAR(); \
    const lds_cptr vp_=vp0+sl_prev; \
    { const l64x2 m0_=__builtin_bit_cast(l64x2,MC0), m1_=__builtin_bit_cast(l64x2,MC1); C0=MFMA8(m0_[0],id0,negm); C1=MFMA8(m1_[0],id0,negm); C0=MFMA8(m0_[1],id1,C0); C1=MFMA8(m1_[1],id1,C1); } SBAR(); \
    VRD(0); SBAR(); float sacc=(P0[0]+P0[1]); \
    GAPA(C0=__builtin_amdgcn_mfma_f32_32x32x16_bf16(kf[0],qr[0],C0,0,0,0), P0[2],P0[3],P0[4],P0[5],     pw0[0]=PKW(P0,0), pw0[1]=PKW(P0,2), pw0); \
    VRD(4); SBAR(); GAPA(C1=__builtin_amdgcn_mfma_f32_32x32x16_bf16(kf[1],qr[0],C1,0,0,0), P0[6],P0[7],P0[8],P0[9],     pw0[2]=PKW(P0,4), pw0[3]=PKW(P0,6), pw0); \
    VRD(1); SBAR(); GAPA(C0=__builtin_amdgcn_mfma_f32_32x32x16_bf16(kf[2],qr[1],C0,0,0,0),   P0[10],P0[11],P0[12],P0[13], pw1[0]=PKW(P0,8), pw1[1]=PKW(P0,10), pw1); \
    VRD(5); SBAR(); GAPA(C1=__builtin_amdgcn_mfma_f32_32x32x16_bf16(kf[3],qr[1],C1,0,0,0),   P0[14],P0[15],P1[0],P1[1],   pw1[2]=PKW(P0,12),pw1[3]=PKW(P0,14), pw1); \
    VRD(2); SBAR(); GAPA(C0=__builtin_amdgcn_mfma_f32_32x32x16_bf16(kf[4],qr[2],C0,0,0,0),   P1[2],P1[3],P1[4],P1[5],     pw2[0]=PKW(P1,0), pw2[1]=PKW(P1,2), pw2); \
    VRD(6); SBAR(); GAPA(C1=__builtin_amdgcn_mfma_f32_32x32x16_bf16(kf[5],qr[2],C1,0,0,0),   P1[6],P1[7],P1[8],P1[9],     pw2[2]=PKW(P1,4), pw2[3]=PKW(P1,6), pw2); \
    VRD(3); SBAR(); GAPA(C0=__builtin_amdgcn_mfma_f32_32x32x16_bf16(kf[6],qr[3],C0,0,0,0),   P1[10],P1[11],P1[12],P1[13], pw3[0]=PKW(P1,8), pw3[1]=PKW(P1,10), pw3); \
    VRD(7); SBAR(); GAPA(C1=__builtin_amdgcn_mfma_f32_32x32x16_bf16(kf[7],qr[3],C1,0,0,0),   P1[14],P1[15],0.f,0.f,       pw3[2]=PKW(P1,12),pw3[3]=PKW(P1,14), pw3); \
    l_reg+=sacc; \
    if(GV){MLOAD(MN0,mp+(size_t)((t)+1)*2048,0);MLOAD(MN1,mp+(size_t)((t)+1)*2048,1024);} if(GK){DMA_K((t)+3,sl_cur);} if(GV){DMA_V((t)+1,sl_next);} \
    { float a=MX3(C0[0],C0[1],C1[0]),b=MX3(C0[2],C0[3],C1[1]); a=MX3(a,C1[2],C1[3]); \
      _Pragma("unroll") for(int r=4;r<16;r+=4){a=MX3(a,C0[r],C0[r+1]);b=MX3(b,C0[r+2],C0[r+3]);a=MX3(a,C1[r],C1[r+1]);b=MX3(b,C1[r+2],C1[r+3]);} \
      float rm=__builtin_fmaxf(a,b); { auto rr=__builtin_amdgcn_permlane32_swap(__float_as_uint(rm),__float_as_uint(rm),false,false); rm=__builtin_fmaxf(__uint_as_float(rr[0]),__uint_as_float(rr[1])); } \
      resc=false; \
      if(__builtin_expect(__any(rm>(float)THRL),0)){ const float dl=__builtin_fmaxf(rm,0.f); mhat+=dl; \
        _Pragma("unroll") for(int r=0;r<16;++r){C0[r]-=dl;C1[r]-=dl;} \
        _Pragma("unroll") for(int r=0;r<16;++r)negm[r]=-mhat; asm volatile("":"+v"(negm)); \
        const float f=__builtin_amdgcn_exp2f(-dl); l_reg*=f; if(hi==0)wsf[r32]=f; resc=true; } } \
    SBAR(); \
    GAPB(o[0]=__builtin_amdgcn_mfma_f32_32x32x16_bf16(PAF(0),VFR(0),o[0],0,0,0), C0,0); \
    GAPB(o[1]=__builtin_amdgcn_mfma_f32_32x32x16_bf16(PAF(0),VFR(4),o[1],0,0,0), C0,4); \
    KRD(GL,0); GAPB(o[0]=__builtin_amdgcn_mfma_f32_32x32x16_bf16(PAF(1),VFR(1),o[0],0,0,0), C0,8); \
    KRD(GL,1); GAPB(o[1]=__builtin_amdgcn_mfma_f32_32x32x16_bf16(PAF(1),VFR(5),o[1],0,0,0), C0,12); \
    KRD(GL,2); GAPB(o[0]=__builtin_amdgcn_mfma_f32_32x32x16_bf16(PAF(2),VFR(2),o[0],0,0,0), C1,0); \
    KRD(GL,3); GAPB(o[1]=__builtin_amdgcn_mfma_f32_32x32x16_bf16(PAF(2),VFR(6),o[1],0,0,0), C1,4); \
    GAPB(o[0]=__builtin_amdgcn_mfma_f32_32x32x16_bf16(PAF(3),VFR(3),o[0],0,0,0), C1,8); \
    GAPB(o[1]=__builtin_amdgcn_mfma_f32_32x32x16_bf16(PAF(3),VFR(7),o[1],0,0,0), C1,12); \
    }while(0)
  int t=1;
  #undef CMASK
  #define CMASK(P0,P1,t) do{}while(0)
  for(;t+5<NT;t+=2){
    STEP(pB0,pB1,pA0,pA1,t,true,true,true,mkB0,mkB1,mkA0,mkA1);     WAIT_BAR(2); PIN2(mkA0,mkA1); RESC(); ROT();
    STEP(pA0,pA1,pB0,pB1,t+1,true,true,true,mkA0,mkA1,mkB0,mkB1);   WAIT_BAR(2); PIN2(mkB0,mkB1); RESC(); ROT();
  }
  #undef CMASK
  #define CMASK(P0,P1,t) do{}while(0)
  #define ENDW(tt) do{ if((tt)+3<NT){WAIT_BAR(2);} else if((tt)+2<NT){WAIT_BAR(1);} else {WAIT_BAR(0);} }while(0)
  for(;t+1<NT;t+=2){
    STEP(pB0,pB1,pA0,pA1,t,(t+3<NT),(t+1<NT),(t+1<NT),mkB0,mkB1,mkA0,mkA1);       ENDW(t);   PIN2(mkA0,mkA1); RESC(); ROT();
    STEP(pA0,pA1,pB0,pB1,t+1,(t+4<NT),(t+2<NT),(t+2<NT),mkA0,mkA1,mkB0,mkB1);     ENDW(t+1); PIN2(mkB0,mkB1); RESC(); ROT();
  }
  STEP(pB0,pB1,pA0,pA1,NT-1,false,false,false,mkB0,mkB1,mkA0,mkA1); RESC();
  { float sacc=pB0[0]+pB0[1]; _Pragma("unroll") for(int r=2;r<16;++r)sacc+=pB0[r]; _Pragma("unroll") for(int r=0;r<16;++r)sacc+=pB1[r]; l_reg+=sacc;
    pw0=(u32x4){PKW(pB0,0),PKW(pB0,2),PKW(pB0,4),PKW(pB0,6)};pw1=(u32x4){PKW(pB0,8),PKW(pB0,10),PKW(pB0,12),PKW(pB0,14)};pw2=(u32x4){PKW(pB1,0),PKW(pB1,2),PKW(pB1,4),PKW(pB1,6)};pw3=(u32x4){PKW(pB1,8),PKW(pB1,10),PKW(pB1,12),PKW(pB1,14)};
    SBAR(); pv(o,vb0+sl_cur,PAF(0),PAF(1),PAF(2),PAF(3)); }
  #undef PKW
  #undef PAF
  #undef VFR
  #undef PIN
  #undef MX3
  #undef GAPA
  #undef GAPB
  #undef EX
  #undef VRD
  #undef KRD
  #undef STEP
  #undef ENDW
  {auto rr=__builtin_amdgcn_permlane32_swap(__float_as_uint(l_reg),__float_as_uint(l_reg),false,false);l_reg=__uint_as_float(rr[0])+__uint_as_float(rr[1]);}
  if(hi==0)wsf[32+r32]=l_reg;asm volatile("s_waitcnt lgkmcnt(0)":::"memory");
  float rli[16];
  #pragma unroll
  for(int r=0;r<16;++r)rli[r]=__builtin_amdgcn_rcpf(wsf[32+crow(r,hi)]);
  { bf16*stg=(bf16*)(shm+LDS_OST)+wid*2048;
    #pragma unroll
    for(int r=0;r<16;++r){const int orow=crow(r,hi);
      #pragma unroll
      for(int d0=0;d0<2;++d0)stg[orow*64+d0*32+r32]=__float2bfloat16(o[d0][r]*rli[r]);}
    asm volatile("s_waitcnt lgkmcnt(0)":::"memory");
    const long grow0=rowbase+q0+wid*QBLK;
    #pragma unroll
    for(int i=0;i<4;++i){const int row=i*8+(lane>>3),ch=lane&7; const u32x4 v=*(const u32x4*)(stg+row*64+ch*8);
      const long grow=grow0+qperm(row);
      const u32x4 az=*(const u32x4*)(AZ+grow*DM+h*D+ch*8);
      const float4 g0=*(const float4*)(gn+h*D+ch*8), g1=*(const float4*)(gn+h*D+ch*8+4);
      float x[8],z[8];
      #pragma unroll
      for(int e=0;e<4;++e){x[2*e]=__uint_as_float(v[e]<<16);x[2*e+1]=__uint_as_float(v[e]&0xffff0000u);z[2*e]=__uint_as_float(az[e]<<16);z[2*e+1]=__uint_as_float(az[e]&0xffff0000u);}
      float ss=0.f;
      #pragma unroll
      for(int e=0;e<8;++e)ss+=x[e]*x[e];
      ss+=__shfl_xor(ss,1);ss+=__shfl_xor(ss,2);ss+=__shfl_xor(ss,4);
      const float inv=1.f/sqrtf(ss*(1.f/64.f)+1e-6f);
      const float gg[8]={g0.x,g0.y,g0.z,g0.w,g1.x,g1.y,g1.z,g1.w};
      unsigned short hv[8];
      #pragma unroll
      for(int e=0;e<8;++e){const float y=x[e]*inv*gg[e]*(z[e]/(1.f+__expf(-z[e]))); hv[e]=__builtin_bit_cast(unsigned short,(_Float16)y);}
      u32x4 ov; ov[0]=hv[0]|((unsigned)hv[1]<<16);ov[1]=hv[2]|((unsigned)hv[3]<<16);ov[2]=hv[4]|((unsigned)hv[5]<<16);ov[3]=hv[6]|((unsigned)hv[7]<<16);
      *(u32x4*)(Y+grow*1024+512+h*D+ch*8)=ov;} }
  asm volatile("s_waitcnt lgkmcnt(0)\n\ts_barrier":::"memory");
  #undef DMA_K
  #undef DMA_V
  #undef CMASK
  #undef START
  #undef RESC
  #undef ROT
}
constexpr int ATTN_LDS_BYTES=LDS_BYTES;
struct AttnTensors { const bf16* Q; const bf16* K; const bf16* V; const unsigned char* MB; const bf16* AZ; const float* gn; unsigned short* Y; };
struct AttnUnit { int bh; int qb; };
struct StaticOrder {
  int vcu;
  __device__ __forceinline__ explicit StaticOrder(int grid,int block):vcu((block%8)*(grid/8)+block/8){}
  __device__ __forceinline__ bool next(int i,AttnUnit&u)const{ if(i>=2)return false; const int s=vcu&7; u.bh=vcu>>3; u.qb=(i==0)?s:15-s; return true; }
  __device__ __forceinline__ void a_ready(const AttnUnit&)const{}
  __device__ __forceinline__ void done(const AttnUnit&)const{}
};
template<class Sched,int THRL=8> __device__ __forceinline__ void attn_phase(char*lds,const AttnTensors&T,const Sched&S){
  AttnUnit u;
  for(int i=0;S.next(i,u);++i){ S.a_ready(u); attn_unit<THRL>(u.bh/NHEAD,u.bh%NHEAD,u.qb,T.Q,T.K,T.V,T.MB,T.AZ,T.gn,T.Y,lds); S.done(u); }
}
#undef SBAR
#undef WAIT_BAR
}

namespace idx_body {
#define IDX_LAS __attribute__((address_space(3)))
typedef _Float16 f16x8 __attribute__((ext_vector_type(8)));
typedef float f32x16 __attribute__((ext_vector_type(16)));
typedef unsigned u32x4 __attribute__((ext_vector_type(4)));
typedef unsigned u32x2 __attribute__((ext_vector_type(2)));
constexpr int SEQ = 4096, PITCH = 768, KOFF = 512, TOPK = 256;
constexpr int LDS_HIST = 0, HROW = 4096, LDS_KS = 32 * HROW, KSLOT = 8192, LDS_BYTES = LDS_KS + 2 * KSLOT;
constexpr int CAND_CAP = 512;
__device__ __forceinline__ void glds16(const void* gsrc, unsigned lds_dst) { unsigned keep;
    asm volatile("s_mov_b32 %0, m0\n\ts_mov_b32 m0, %2\n\ts_nop 0\n\tglobal_load_lds_dwordx4 %1, off\n\ts_mov_b32 m0, %0" : "=&s"(keep) : "v"(gsrc), "s"(lds_dst) : "memory"); }
#define IDX_WAIT_BAR() asm volatile("s_waitcnt vmcnt(0) lgkmcnt(0)\n\ts_barrier" ::: "memory")
__device__ __forceinline__ unsigned okey(float s) { const unsigned u = __float_as_uint(s); return u ^ ((unsigned)((int)u >> 31) | 0x80000000u); }
__device__ __forceinline__ int wsum(int v) {
#pragma unroll
    for (int o = 1; o < 64; o <<= 1) v += __shfl_xor(v, o);
    return v;
}
struct IdxTensors { const unsigned short* IDX; const float* IW; unsigned char* MB; };

__device__ __forceinline__ void scores2(float (&sc)[2], const f16x8 (&af)[4], const float (&wv)[16], IDX_LAS const unsigned char* ks, int r32, int hi, int kb) {
    f32x16 acc = {};
#pragma unroll
    for (int s = 0; s < 4; ++s) { const f16x8 bfr = *(IDX_LAS const f16x8*)(ks + (2 * s + hi) * 1024 + (32 * kb + r32) * 16);
        acc = __builtin_amdgcn_mfma_f32_32x32x16_f16(af[s], bfr, acc, 0, 0, 0); }
#pragma unroll
    for (int u = 0; u < 2; ++u) { float a = 0.f;
#pragma unroll
        for (int h = 0; h < 8; ++h) a = fmaf(wv[8 * u + h], fmaxf(acc[8 * u + h], 0.f), a);
        sc[u] = a; }
}

__device__ __forceinline__ void idx_unit(int b, int QB, const IdxTensors& T, IDX_LAS unsigned char* lds) {
    const int tid = threadIdx.x, lane = tid & 63, r32 = lane & 31, hi = lane >> 5; const int wid = __builtin_amdgcn_readfirstlane(tid >> 6);
    const long rowbase = (long)b * SEQ; const int q0 = QB * 32;
    f16x8 af[4];
    { const int i = r32, head = (i & 3) + 4 * ((i >> 3) & 1), qi = 2 * ((i >> 2) & 1) + (i >> 4);
      const unsigned short* src = T.IDX + (rowbase + q0 + 4 * wid + qi) * PITCH + head * 64 + 8 * hi;
#pragma unroll
      for (int s = 0; s < 4; ++s) af[s] = *(const f16x8*)(src + 16 * s); }
    float wv[16];
#pragma unroll
    for (int u = 0; u < 2; ++u) { const float* wp = T.IW + (rowbase + q0 + 4 * wid + 2 * hi + u) * 8; const float4 a = *(const float4*)wp, c = *(const float4*)(wp + 4);
        wv[8 * u + 0] = a.x; wv[8 * u + 1] = a.y; wv[8 * u + 2] = a.z; wv[8 * u + 3] = a.w; wv[8 * u + 4] = c.x; wv[8 * u + 5] = c.y; wv[8 * u + 6] = c.z; wv[8 * u + 7] = c.w; }
    const int myq0 = q0 + 4 * wid + 2 * hi;
    IDX_LAS unsigned char* hrow0 = lds + LDS_HIST + (4 * wid + 2 * hi) * HROW;
    const unsigned lds0 = (unsigned)(uintptr_t)lds;
    const int nblk = QB + 1, nchunk = (nblk + 1) >> 1;
    const unsigned short* ksrc = T.IDX + (rowbase + lane) * PITCH + KOFF + 8 * wid;
    const unsigned kdst = lds0 + LDS_KS + wid * 1024;
#define IDX_DMA(c) glds16(ksrc + (long)(c) * 64 * PITCH, (unsigned)__builtin_amdgcn_readfirstlane(kdst + ((c) & 1) * KSLOT))
    { const u32x4 z = {0u, 0u, 0u, 0u};
#pragma unroll
      for (int i = 0; i < 16; ++i) *(IDX_LAS u32x4*)(lds + LDS_HIST + (i * 512 + tid) * 16) = z; }
    IDX_DMA(0);
    IDX_WAIT_BAR();
    for (int c = 0; c < nchunk; ++c) {
        if (c + 1 < nchunk) IDX_DMA(c + 1);
        IDX_LAS const unsigned char* ks = lds + LDS_KS + (c & 1) * KSLOT;
#pragma unroll
        for (int kb = 0; kb < 2; ++kb) { const int KB = 2 * c + kb;
            if (KB < nblk) { float sc[2]; scores2(sc, af, wv, ks, r32, hi, kb);
#pragma unroll
                for (int u = 0; u < 2; ++u) { const unsigned key = okey(sc[u]); const unsigned bin = key >> 21;
                    const bool valid = (KB < QB) || (32 * KB + r32 <= myq0 + u);
                    if (valid) __hip_atomic_fetch_add((IDX_LAS unsigned*)(hrow0 + u * HROW) + (bin >> 1), 1u << (16 * (bin & 1)), __ATOMIC_RELAXED, __HIP_MEMORY_SCOPE_WORKGROUP); } } }
        IDX_WAIT_BAR();
    }
    int bst[4], nab[4];
#pragma unroll
    for (int j = 0; j < 4; ++j) {
        IDX_LAS const u32x4* hr = (IDX_LAS const u32x4*)(lds + LDS_HIST + (4 * wid + j) * HROW) + 4 * lane;
        unsigned wds[16]; int tot = 0;
#pragma unroll
        for (int i = 0; i < 4; ++i) { const u32x4 v = hr[i]; wds[4 * i] = v.x; wds[4 * i + 1] = v.y; wds[4 * i + 2] = v.z; wds[4 * i + 3] = v.w; }
#pragma unroll
        for (int i = 0; i < 16; ++i) tot += (int)(wds[i] & 0xffffu) + (int)(wds[i] >> 16);
        int v = tot;
#pragma unroll
        for (int o = 1; o < 64; o <<= 1) { const int t = __shfl_down(v, o); if (lane + o < 64) v += t; }
        const int excl = v - tot;
        const bool has = (excl < TOPK) && (v >= TOPK);
        int bl = 0, na = 0; { int cum = excl; bool found = false;
#pragma unroll
            for (int i = 31; i >= 0; --i) { const int cnt = (int)((wds[i >> 1] >> (16 * (i & 1))) & 0xffffu);
                if (!found && cum + cnt >= TOPK) { found = true; bl = 32 * lane + i; na = cum; }
                if (!found) cum += cnt; } }
        const unsigned long long bm = __ballot(has);
        const int src = bm ? (int)__builtin_ctzll(bm) : 0;
        bst[j] = __shfl(bl, src); nab[j] = __shfl(na, src);
    }
    asm volatile("s_waitcnt lgkmcnt(0)" ::: "memory");
    const int bstar0 = hi ? bst[2] : bst[0], bstar1 = hi ? bst[3] : bst[1];
    int cb[4] = {0, 0, 0, 0};
    unsigned char* mrow = T.MB + ((size_t)(b * 128 + QB) * 128) * 1024 + (hi * 32 + r32) * 16 + (wid >> 2) * 8 + 2 * (wid & 3);
    IDX_DMA(0);
    IDX_WAIT_BAR();
    for (int c = 0; c < nchunk; ++c) {
        if (c + 1 < nchunk) IDX_DMA(c + 1);
        IDX_LAS const unsigned char* ks = lds + LDS_KS + (c & 1) * KSLOT;
#pragma unroll
        for (int kb = 0; kb < 2; ++kb) { const int KB = 2 * c + kb; unsigned bytes = 0xE4E4u;
            if (KB < nblk) { float sc[2]; scores2(sc, af, wv, ks, r32, hi, kb);
#pragma unroll
                for (int u = 0; u < 2; ++u) { const unsigned key = okey(sc[u]); const int bin = (int)(key >> 21); const int bstar = u ? bstar1 : bstar0;
                    const bool valid = (KB < QB) || (32 * KB + r32 <= myq0 + u);
                    const bool sel = valid && bin > bstar, cand = valid && bin == bstar;
                    if (sel) bytes &= u ? 0x00ffu : 0xff00u;
                    const unsigned long long bl = __ballot(cand);
                    if (bl) { const unsigned lo = (unsigned)bl, hh = (unsigned)(bl >> 32);
                        const int pos = (hi ? cb[2 + u] : cb[u]) + __popc((hi ? hh : lo) & ((1u << r32) - 1u));
                        if (cand && pos < CAND_CAP) *((IDX_LAS u32x2*)(hrow0 + u * HROW) + pos) = (u32x2){key, (unsigned)(32 * KB + r32)};
                        cb[u] += __popc(lo); cb[2 + u] += __popc(hh); } } }
            *(unsigned short*)(mrow + (size_t)KB * 1024) = (unsigned short)bytes; }
        IDX_WAIT_BAR();
    }
    { const u32x4 e4 = {0xE4E4E4E4u, 0xE4E4E4E4u, 0xE4E4E4E4u, 0xE4E4E4E4u};
      for (int KB = 2 * nchunk + wid; KB <= (QB | 7); KB += 8) *(u32x4*)(T.MB + ((size_t)(b * 128 + QB) * 128 + KB) * 1024 + lane * 16) = e4; }
    asm volatile("s_waitcnt vmcnt(0) lgkmcnt(0)" ::: "memory");
#pragma unroll
    for (int j = 0; j < 4; ++j) {
        const int nc = cb[j] < CAND_CAP ? cb[j] : CAND_CAP; const int need = TOPK - nab[j];
        IDX_LAS const u32x2* cl = (IDX_LAS const u32x2*)(lds + LDS_HIST + (4 * wid + j) * HROW);
        unsigned ke[8], ie[8];
#pragma unroll
        for (int i = 0; i < 8; ++i) { const int e = lane + 64 * i; if (e < nc) { const u32x2 v = cl[e]; ke[i] = v.x; ie[i] = v.y; } else { ke[i] = 0u; ie[i] = 0xffffu; } }
        unsigned Tk = (unsigned)bst[j] << 21;
        for (int bit = 20; bit >= 0; --bit) { const unsigned cand = Tk | (1u << bit); int cnt = 0;
#pragma unroll
            for (int i = 0; i < 8; ++i) cnt += (ke[i] >= cand) ? 1 : 0;
            if (wsum(cnt) >= need) Tk = cand; }
        int cgt = 0, cti = 0;
#pragma unroll
        for (int i = 0; i < 8; ++i) { cgt += (ke[i] > Tk) ? 1 : 0; cti += (ke[i] == Tk) ? 1 : 0; }
        cgt = wsum(cgt); cti = wsum(cti);
        const int need2 = need - cgt;
        unsigned It = 4095u;
        if (need2 < cti) { It = 0u;
            for (int bit = 11; bit >= 0; --bit) { const unsigned t = It | (1u << bit); int cnt = 0;
#pragma unroll
                for (int i = 0; i < 8; ++i) cnt += (ke[i] == Tk && ie[i] < t) ? 1 : 0;
                if (wsum(cnt) < need2) It = t; } }
        const int jh = j >> 1, ju = j & 1;
        unsigned char* prow = T.MB + ((size_t)(b * 128 + QB) * 128) * 1024 + (jh * 32) * 16 + (wid >> 2) * 8 + 2 * (wid & 3) + ju;
#pragma unroll
        for (int i = 0; i < 8; ++i) { const bool selc = (ke[i] > Tk) || (ke[i] == Tk && ie[i] <= It && ke[i] != 0u);
            if (selc) prow[(size_t)(ie[i] >> 5) * 1024 + (ie[i] & 31) * 16] = 0x00; }
    }
    IDX_WAIT_BAR();
#undef IDX_DMA
}
__device__ __forceinline__ void idx_trivial_block(int b, int QB, int KB, unsigned char* MB, int lane) {
    const int hi = lane >> 5, key = 32 * KB + (lane & 31); unsigned w[4] = {0u, 0u, 0u, 0u};
#pragma unroll
    for (int sj = 0; sj < 16; ++sj) { const int s = sj >> 3, j = sj & 7; const int q = 32 * QB + 4 * (4 * s + (j >> 1)) + 2 * hi + (j & 1);
        w[sj >> 2] |= ((key <= q) ? 0x00u : 0xE4u) << (8 * (sj & 3)); }
    *(u32x4*)(MB + ((size_t)(b * 128 + QB) * 128 + KB) * 1024 + lane * 16) = (u32x4){w[0], w[1], w[2], w[3]};
}
__device__ __forceinline__ void idx_phase(IDX_LAS unsigned char* lds, const IdxTensors& T, int v, int G) {
    const int lane = threadIdx.x & 63; const int wid = __builtin_amdgcn_readfirstlane((int)threadIdx.x >> 6);
    if (G >= 256) {
        if (v < 240) { const int b = v / 60, i = v % 60; idx_unit(b, 127 - i, T, lds); idx_unit(b, 8 + i, T, lds); }
        else { for (int k = (v - 240) * 8 + wid; k < 256; k += (G - 240) * 8) idx_trivial_block(k >> 6, (k >> 3) & 7, k & 7, T.MB, lane); }
    } else {
        for (int un = v; un < 480; un += G) { const int b = un / 120, i = un % 120; idx_unit(b, 127 - i, T, lds); }
        for (int k = v * 8 + wid; k < 256; k += G * 8) idx_trivial_block(k >> 6, (k >> 3) & 7, k & 7, T.MB, lane);
    }
}
#undef IDX_WAIT_BAR
}

#define GAS __attribute__((address_space(1)))
#define LAS __attribute__((address_space(3)))
typedef unsigned short bf16;
typedef unsigned v4u __attribute__((ext_vector_type(4)));
typedef float f32x4 __attribute__((ext_vector_type(4)));
typedef short bf16x8 __attribute__((ext_vector_type(8)));
typedef GAS unsigned gu32;
typedef GAS unsigned long long gu64;
#define RLX_AGENT __ATOMIC_RELAXED, __HIP_MEMORY_SCOPE_AGENT
#define LDS_WAIT() asm volatile("s_waitcnt lgkmcnt(0)" ::: "memory")
#define VM_WAIT() asm volatile("s_waitcnt vmcnt(0)" ::: "memory")
__device__ __forceinline__ unsigned long long rt() { return __builtin_amdgcn_s_memrealtime(); }
__device__ __forceinline__ unsigned f2bf(float f) { unsigned u = __builtin_bit_cast(unsigned, f); return (u + 0x7fffu + ((u >> 16) & 1u)) >> 16; }
__device__ __forceinline__ unsigned pk2(float lo, float hi) { return f2bf(lo) | (f2bf(hi) << 16); }

#define XB_TMO      128
#define XB_XCNT(j)  (256  + 64 * (j))
#define XB_XSUB(j)  (1280 + 64 * (j))
#define XB_XGEN(j)  (2304 + 64 * (j))
#define XB_TOP      3328
#define XB_TOPGEN   3392
#define XCD_BAR_WORDS 3456
#define XB_SPIN_CAP (1u << 18)

__device__ __forceinline__ unsigned xb_ld(unsigned* p)              { return __hip_atomic_load(p, __ATOMIC_RELAXED, __HIP_MEMORY_SCOPE_AGENT); }
__device__ __forceinline__ unsigned xb_add(unsigned* p, unsigned v) { return __hip_atomic_fetch_add(p, v, __ATOMIC_RELAXED, __HIP_MEMORY_SCOPE_AGENT); }
__device__ __forceinline__ unsigned xb_xcc_id() { return (unsigned)__builtin_amdgcn_s_getreg((3 << 11) | 20) & 0xFu; }
#define XB_SPIN(cond, bar) do { unsigned _sp = 0; while (cond) { __builtin_amdgcn_s_sleep(1); \
    if ((++_sp & 255u) == 0u) { if (xb_ld(&(bar)[XB_TMO])) break; if (_sp > XB_SPIN_CAP) { atomicAdd(&(bar)[XB_TMO], 1u); break; } } } } while (0)

struct XcdBarrier {
    unsigned* bar; unsigned x;
    volatile LAS unsigned* st;
};

__device__ __forceinline__ XcdBarrier xcd_barrier_post(unsigned* bar, volatile LAS unsigned* st) {
    XcdBarrier b; b.bar = bar; b.x = xb_xcc_id(); b.st = st;
    if (threadIdx.x == 0) (void)xb_add(&bar[XB_XCNT(b.x)], 1u);
    return b;
}
__device__ __forceinline__ void xcd_barrier_complete(unsigned* bar, unsigned x, unsigned& nloc, unsigned& nx) {
    const unsigned G = gridDim.x * gridDim.y * gridDim.z;
    unsigned sum, cnt, mine, sp = 0u;
    for (;;) {
        sum = 0u; cnt = 0u; mine = 0u;
#pragma unroll
        for (unsigned j = 0; j < 16; ++j) { const unsigned c = xb_ld(&bar[XB_XCNT(j)]); sum += c; cnt += (c > 0u) ? 1u : 0u; mine = (j == x) ? c : mine; }
        if (sum == G) break;
        __builtin_amdgcn_s_sleep(1);
        if ((++sp & 255u) == 0u) { if (xb_ld(&bar[XB_TMO])) break; if (sp > XB_SPIN_CAP) { atomicAdd(&bar[XB_TMO], 1u); break; } }
    }
    nloc = mine > 0u ? mine : 1u; nx = cnt > 0u ? cnt : 1u;
}

__device__ __forceinline__ void xcd_barrier(const XcdBarrier& b) {
    asm volatile("s_waitcnt vmcnt(0)" ::: "memory");
    __syncthreads();
    if (threadIdx.x == 0) {
        unsigned* bar = b.bar;
        __builtin_amdgcn_s_waitcnt(0);
        unsigned nloc = b.st[0], nx = b.st[1];
        if (nloc == 0u) { xcd_barrier_complete(bar, b.x, nloc, nx); b.st[0] = nloc; b.st[1] = nx; }
        const unsigned old = xb_add(&bar[XB_XSUB(b.x)], 1u);
        const unsigned gen = old / nloc;
        if (old + 1u == (gen + 1u) * nloc) {
            __builtin_amdgcn_fence(__ATOMIC_RELEASE, "agent");
            asm volatile("s_waitcnt vmcnt(0)" ::: "memory");
            const unsigned og = xb_add(&bar[XB_TOP], 1u);
            const unsigned tg = og / nx;
            if (og + 1u == (tg + 1u) * nx) xb_add(&bar[XB_TOPGEN], 1u);
            else XB_SPIN(xb_ld(&bar[XB_TOPGEN]) == tg, bar);
            __builtin_amdgcn_fence(__ATOMIC_ACQUIRE, "agent");
            xb_add(&bar[XB_XGEN(b.x)], 1u);
            asm volatile("s_waitcnt vmcnt(0)" ::: "memory");
        } else {
            XB_SPIN(xb_ld(&bar[XB_XGEN(b.x)]) == gen, bar);
            __builtin_amdgcn_fence(__ATOMIC_ACQUIRE, "agent");
            asm volatile("s_waitcnt vmcnt(0)" ::: "memory");
        }
    }
    __syncthreads();
}

constexpr int NWAVES = 8;
#ifndef MK_N_LAUNCHES
#define MK_N_LAUNCHES 1
#endif
constexpr int PER_PHASE = 8;
constexpr int N_LAUNCHES = MK_N_LAUNCHES;

constexpr int BATCH = 4, T = 4096, D = 1024, M = BATCH * T;
constexpr int NHEAD = 8, HD = 64, TOPK = 256;
constexpr int D_IN = 4680, NPROJ = 4864;
constexpr int C_CB = 0, C_CC = 512, C_CU = 1024, C_CZ = 1536, C_Q = 2048, C_K = 2560, C_V = 3072, C_AZ = 3584, C_IQ = 4096, C_IK = 4608, C_IW = 4672;
constexpr float EPS = 1e-6f;
constexpr float C2 = 0.125f * 1.4426950408889634f;
constexpr float IWSCALE = 0.35355339059327373f * 0.125f;

constexpr size_t MiB = 1u << 20;
constexpr size_t WS_CTL = 0, CTL_ZERO_BYTES = 1 * MiB;
constexpr size_t WS_ROPE = 1 * MiB;
constexpr size_t WS_IW = 2 * MiB;
constexpr size_t WS_WIN = 4 * MiB;
constexpr size_t WS_WOUT = 14 * MiB;
constexpr size_t WS_H = 16 * MiB;
constexpr size_t WS_YCAT = WS_H;
constexpr size_t WS_CONV = 48 * MiB;
constexpr size_t WS_MASKB = WS_CONV;
constexpr size_t WS_ATT = 112 * MiB;
constexpr size_t WS_IDX = 176 * MiB;
constexpr size_t WS_END = 200 * MiB;
constexpr int CW_TMO = 0, CW_CODE = 1, CW_BAR = 4096, CW_MOD = 131072;
static_assert((CW_MOD + BATCH * 3 * D) * 4 <= (int)CTL_ZERO_BYTES, "ctl map");

constexpr int RING_OFF = 0, RING_BYTES = 147456;
constexpr int LDSCTL_OFF = RING_BYTES, MISC_OFF = LDSCTL_OFF + 320;
constexpr int LDS_BYTES = RING_BYTES + 1024;

typedef unsigned short u16;
__device__ __forceinline__ float bf2f(u16 v) { return __uint_as_float((unsigned)v << 16); }
__device__ __forceinline__ float h2f(u16 v) { return (float)__builtin_bit_cast(_Float16, v); }
__device__ __forceinline__ u16 f2h(float f) { return __builtin_bit_cast(u16, (_Float16)f); }
__device__ __forceinline__ unsigned pk2h(float lo, float hi) { return (unsigned)f2h(lo) | ((unsigned)f2h(hi) << 16); }
__device__ __forceinline__ float siluf(float z) { return z / (1.f + __expf(-z)); }

struct Args { const void* in[13]; float* out; unsigned char* ws; float if0, if1, if2, if3, if4, if5, if6, if7; int ph_lo, ph_hi; };
struct Frame {
    LAS unsigned char* lds;
    volatile LAS unsigned* MISC;
    gu32* ctl;
    int tid, lane, wave, vcu, G;
    const float *x, *c, *w_ada, *b_ada, *norm_in, *w_in, *conv_w, *conv_b, *gn_conv, *gn_attn, *w_out, *norm_f; const int* positions;
    float* out; float* MOD; float* ROPE; float* IW;
    u16 *WIN, *WOUT, *H, *CONV, *ATT, *IDX, *YCAT; unsigned char* MASKB;
};
__device__ __forceinline__ float wave_sum(float v) {
#pragma unroll
    for (int o = 1; o < 64; o <<= 1) v += __shfl_xor(v, o);
    return v;
}
__device__ __forceinline__ int wave_sum_i(int v) {
#pragma unroll
    for (int o = 1; o < 64; o <<= 1) v += __shfl_xor(v, o);
    return v;
}
__device__ __forceinline__ float wave_max(float v) {
#pragma unroll
    for (int o = 1; o < 64; o <<= 1) v = fmaxf(v, __shfl_xor(v, o));
    return v;
}
__device__ __forceinline__ void p0_transpose_item(const float* W, int K, int N, int Npad, u16* WT, LAS float* scr, int item, int lane) {
    const int nblk = Npad / 32, kb = item / nblk, nb = item % nblk, k0 = 64 * kb, n0 = 32 * nb;
    const int n_in = n0 + (lane & 31);
#pragma unroll 8
    for (int i = 0; i < 32; ++i) { const int kk = 2 * i + (lane >> 5); scr[kk * 33 + (lane & 31)] = (n_in < N) ? W[(size_t)(k0 + kk) * N + n_in] : 0.f; }
    LDS_WAIT(); asm volatile("" ::: "memory");
    const int c = lane & 7;
#pragma unroll
    for (int j = 0; j < 4; ++j) { const int n = (lane >> 3) + 8 * j; const LAS float* s = scr + (8 * c) * 33 + n;
        v4u o; o.x = pk2h(s[0 * 33], s[1 * 33]); o.y = pk2h(s[2 * 33], s[3 * 33]); o.z = pk2h(s[4 * 33], s[5 * 33]); o.w = pk2h(s[6 * 33], s[7 * 33]);
        *(GAS v4u*)(WT + (size_t)(n0 + n) * K + k0 + 8 * c) = o; }
    LDS_WAIT(); asm volatile("" ::: "memory");
}
__device__ __forceinline__ void sincos_acc(float ang, float& sn, float& cs) {
    double rev = (double)ang * 0.15915494309189535; rev -= floor(rev);
    const int q = (int)(rev * 4.0 + 0.5);
    const float th = (float)((rev - 0.25 * (double)q) * 6.283185307179586);
    const float t2 = th * th;
    const float s = th * (1.f + t2 * (-1.f / 6.f + t2 * (1.f / 120.f + t2 * (-1.f / 5040.f + t2 * (1.f / 362880.f)))));
    const float c = 1.f + t2 * (-0.5f + t2 * (1.f / 24.f + t2 * (-1.f / 720.f + t2 * (1.f / 40320.f))));
    switch (q & 3) { case 0: sn = s; cs = c; break; case 1: sn = c; cs = -s; break; case 2: sn = -s; cs = -c; break; default: sn = -c; cs = s; break; }
}

__device__ __forceinline__ void p0_prologue(Frame& F, const Args& A) {
    LAS float* scr = (LAS float*)(F.lds + RING_OFF + F.wave * 16384);
    const int gw = F.vcu * NWAVES + F.wave, NGW = F.G * NWAVES;
    constexpr int I_IN = (D / 64) * (NPROJ / 32), I_OUT = (D / 64) * (D / 32), I_MOD = 32 * 48;
    constexpr int NITEMS = I_IN + I_OUT + I_MOD;
    for (int it = gw; it < NITEMS; it += NGW) {
        int r = it;
        if (r < I_IN) { p0_transpose_item(F.w_in, D, D_IN, NPROJ, F.WIN, scr, r, F.lane); continue; } r -= I_IN;
        if (r < I_OUT) { p0_transpose_item(F.w_out, D, D, D, F.WOUT, scr, r, F.lane); continue; } r -= I_OUT;
        {
            const int kc = r / 48, cg = r % 48, col = cg * 64 + F.lane;
            float sv[BATCH];
#pragma unroll
            for (int b = 0; b < BATCH; ++b) sv[b] = siluf(F.c[b * D + kc * 32 + (F.lane & 31)]);
            float acc[BATCH];
#pragma unroll
            for (int b = 0; b < BATCH; ++b) acc[b] = (kc == 0) ? F.b_ada[col] : 0.f;
#pragma unroll 8
            for (int kk = 0; kk < 32; ++kk) { const float wv = F.w_ada[(size_t)(kc * 32 + kk) * (3 * D) + col];
#pragma unroll
                for (int b = 0; b < BATCH; ++b) acc[b] += __shfl(sv[b], kk) * wv; }
#pragma unroll
            for (int b = 0; b < BATCH; ++b) atomicAdd(F.MOD + b * 3 * D + col, acc[b]);
        }
    }
    const int ri = F.lane & 7;
    const float ifr = ri == 0 ? A.if0 : ri == 1 ? A.if1 : ri == 2 ? A.if2 : ri == 3 ? A.if3 : ri == 4 ? A.if4 : ri == 5 ? A.if5 : ri == 6 ? A.if6 : A.if7;
    for (int e = (gw * 64 + F.lane); e < M * 8; e += NGW * 64) { const int m = e >> 3, i = e & 7;
        const float ang = (float)F.positions[m] * ifr; float sn, cs; sincos_acc(ang, sn, cs);
        F.ROPE[m * 16 + i] = cs; F.ROPE[m * 16 + 8 + i] = sn; }
}
__device__ __forceinline__ void p1_rows(Frame& F) {
    const int gw = F.vcu * NWAVES + F.wave, NGW = F.G * NWAVES;
    for (int m = gw; m < M; m += NGW) {
        const int b = m / T;
        const GAS f32x4* xr = (const GAS f32x4*)(F.x + (size_t)m * D) + F.lane;
        f32x4 v[4]; float s = 0.f;
#pragma unroll
        for (int j = 0; j < 4; ++j) { v[j] = xr[64 * j]; s += (v[j].x * v[j].x + v[j].y * v[j].y) + (v[j].z * v[j].z + v[j].w * v[j].w); }
        const float inv = 1.f / sqrtf(wave_sum(s) * (1.f / D) + EPS);
        GAS unsigned long long* o8 = (GAS unsigned long long*)(F.H + (size_t)m * D) + F.lane;
#pragma unroll
        for (int j = 0; j < 4; ++j) { const int col = 4 * F.lane + 256 * j;
            const f32x4 g = *(const f32x4*)(F.norm_in + col), sh = *(const f32x4*)(F.MOD + b * 3 * D + col), sc = *(const f32x4*)(F.MOD + b * 3 * D + D + col);
            const f32x4 h = (v[j] * inv) * g * (sc + 1.f) + sh;
            o8[64 * j] = (unsigned long long)pk2h(h.x, h.y) | ((unsigned long long)pk2h(h.z, h.w) << 32); }
    }
}
__device__ __forceinline__ void p3_rows(Frame& F) {
    const int gw = F.vcu * NWAVES + F.wave, NGW = F.G * NWAVES, lane = F.lane;
    for (int m = gw; m < M; m += NGW) {
        const int t = m % T;
        u16* arow = F.ATT + (size_t)m * 2048; u16* irow = F.IDX + (size_t)m * 768; const u16* prow = F.CONV + (size_t)m * 2048;
        const int h = lane >> 3, i = lane & 7;
        const float cs = F.ROPE[m * 16 + i], sn = F.ROPE[m * 16 + 8 + i];
        { u16* p = arow + h * 64; const float x1 = bf2f(p[i]), x2 = bf2f(p[8 + i]); p[i] = (u16)f2bf(x1 * cs - x2 * sn); p[8 + i] = (u16)f2bf(x1 * sn + x2 * cs); }
        { u16* p = arow + 512 + h * 64; const float x1 = bf2f(p[i]), x2 = bf2f(p[8 + i]); p[i] = (u16)f2bf(x1 * cs - x2 * sn); p[8 + i] = (u16)f2bf(x1 * sn + x2 * cs); }
        { u16* p = irow + h * 64; const float x1 = h2f(p[i]), x2 = h2f(p[8 + i]); p[i] = f2h(x1 * cs - x2 * sn); p[8 + i] = f2h(x1 * sn + x2 * cs); }
        if (h == 0) { u16* p = irow + 512; const float x1 = h2f(p[i]), x2 = h2f(p[8 + i]); p[i] = f2h(x1 * cs - x2 * sn); p[8 + i] = f2h(x1 * sn + x2 * cs); }
        const int c0 = lane * 8;
        const v4u z4 = {0u, 0u, 0u, 0u};
        const v4u cbv = *(const v4u*)(prow + C_CB + c0), czv = *(const v4u*)(prow + C_CZ + c0);
        const v4u cc0 = *(const v4u*)(prow + C_CC + c0), cu0 = *(const v4u*)(prow + C_CU + c0);
        const v4u cc1 = t >= 1 ? *(const v4u*)(prow - 2048 + C_CC + c0) : z4, cu1 = t >= 1 ? *(const v4u*)(prow - 2048 + C_CU + c0) : z4;
        const v4u cc2 = t >= 2 ? *(const v4u*)(prow - 4096 + C_CC + c0) : z4, cu2 = t >= 2 ? *(const v4u*)(prow - 4096 + C_CU + c0) : z4;
        float y[8]; float ss = 0.f;
#pragma unroll
        for (int e = 0; e < 8; ++e) {
            const int wd = e >> 1; const bool hi = e & 1;
#define UNP(v) (hi ? __uint_as_float((v)[wd] & 0xffff0000u) : __uint_as_float((v)[wd] << 16))
            const float s0 = UNP(cc0) * UNP(cu0), s1 = UNP(cc1) * UNP(cu1), s2 = UNP(cc2) * UNP(cu2);
            const int c = c0 + e;
            const float cv = F.conv_b[c] + F.conv_w[c] * s2 + F.conv_w[512 + c] * s1 + F.conv_w[1024 + c] * s0;
            y[e] = UNP(cbv) * cv; ss += y[e] * y[e];
        }
        ss += __shfl_xor(ss, 1); ss += __shfl_xor(ss, 2); ss += __shfl_xor(ss, 4);
        const float inv = 1.f / sqrtf(ss * (1.f / 64.f) + EPS);
        float o[8];
#pragma unroll
        for (int e = 0; e < 8; ++e) { const int wd = e >> 1; const bool hi = e & 1; o[e] = y[e] * inv * F.gn_conv[c0 + e] * siluf(UNP(czv)); }
#undef UNP
        v4u ov; ov.x = pk2h(o[0], o[1]); ov.y = pk2h(o[2], o[3]); ov.z = pk2h(o[4], o[5]); ov.w = pk2h(o[6], o[7]);
        *(v4u*)(F.YCAT + (size_t)m * D + c0) = ov;
    }
}
__device__ __forceinline__ void p7_rows(Frame& F) {
    const int gw = F.vcu * NWAVES + F.wave, NGW = F.G * NWAVES;
    for (int m = gw; m < M; m += NGW) {
        GAS f32x4* xr = (GAS f32x4*)(F.out + (size_t)m * D) + F.lane;
        f32x4 v[4]; float s = 0.f;
#pragma unroll
        for (int j = 0; j < 4; ++j) { v[j] = xr[64 * j]; s += (v[j].x * v[j].x + v[j].y * v[j].y) + (v[j].z * v[j].z + v[j].w * v[j].w); }
        const float inv = 1.f / sqrtf(wave_sum(s) * (1.f / D) + EPS);
#pragma unroll
        for (int j = 0; j < 4; ++j) { const f32x4 g = *(const f32x4*)(F.norm_f + 4 * F.lane + 256 * j); xr[64 * j] = (v[j] * inv) * g; }
    }
}

__global__ void __launch_bounds__(NWAVES * 64, 2) fwd_kernel(Args args) {
    extern __shared__ __attribute__((aligned(16))) unsigned char lds[];
    Frame F;
    F.lds = (LAS unsigned char*)lds;
    F.MISC = (volatile LAS unsigned*)(F.lds + MISC_OFF);
    F.tid = threadIdx.x; F.lane = F.tid & 63; F.wave = __builtin_amdgcn_readfirstlane(F.tid >> 6);
    F.G = gridDim.x; { const int bx = blockIdx.x; F.vcu = (F.G % 8 == 0) ? (bx % 8) * (F.G / 8) + bx / 8 : bx; }
    unsigned char* ws = args.ws;
    F.ctl = (gu32*)(ws + WS_CTL);
    F.x = (const float*)args.in[0]; F.c = (const float*)args.in[1]; F.positions = (const int*)args.in[2]; F.w_ada = (const float*)args.in[3]; F.b_ada = (const float*)args.in[4];
    F.norm_in = (const float*)args.in[5]; F.w_in = (const float*)args.in[6]; F.conv_w = (const float*)args.in[7]; F.conv_b = (const float*)args.in[8];
    F.gn_conv = (const float*)args.in[9]; F.gn_attn = (const float*)args.in[10]; F.w_out = (const float*)args.in[11]; F.norm_f = (const float*)args.in[12];
    F.out = args.out;
    F.MOD = (float*)(ws + WS_CTL) + CW_MOD; F.ROPE = (float*)(ws + WS_ROPE); F.IW = (float*)(ws + WS_IW);
    F.WIN = (u16*)(ws + WS_WIN); F.WOUT = (u16*)(ws + WS_WOUT); F.H = (u16*)(ws + WS_H); F.CONV = (u16*)(ws + WS_CONV); F.ATT = (u16*)(ws + WS_ATT); F.IDX = (u16*)(ws + WS_IDX); F.YCAT = (u16*)(ws + WS_YCAT); F.MASKB = ws + WS_MASKB;
    for (int u = F.tid; u < (LDS_BYTES - LDSCTL_OFF) / 4; u += NWAVES * 64) ((LAS unsigned*)(F.lds + LDSCTL_OFF))[u] = 0u;
    __syncthreads();
    XcdBarrier bar; bar.bar = (unsigned*)(F.ctl + CW_BAR); bar.x = 0; bar.st = nullptr;
    if (N_LAUNCHES != PER_PHASE) bar = xcd_barrier_post((unsigned*)(F.ctl + CW_BAR), F.MISC + 8);
#define GRID_BAR(seam) do { if (N_LAUNCHES == PER_PHASE) { if (F.tid == 0) __hip_atomic_store(F.ctl + CW_TMO, 0xBADBA0u | (unsigned)(seam), RLX_AGENT); } else { xcd_barrier(bar); } } while (0)
    const int lo = args.ph_lo, hi = args.ph_hi;
#define IN(k) (lo <= (k) && (k) < hi)
#define BOTH(k) (IN(k) && IN((k) + 1))
    if (IN(0)) { p0_prologue(F, args); if (BOTH(0)) GRID_BAR(0); }
    if (IN(1)) { p1_rows(F); if (BOTH(1)) GRID_BAR(1); }
    if (IN(2)) {
        pg8::Gemm g{F.H, F.WIN, M, NPROJ, D}; pg8::StaticOrder S; S.init(M, NPROJ, F.G, (int)blockIdx.x);
        pg8::EpiProj E{F.CONV, (size_t)(WS_ATT - WS_CONV) / 2, F.IW, C2, IWSCALE};
        static_assert(WS_IDX - WS_ATT == WS_ATT - WS_CONV, "EpiProj: evenly spaced output arrays");
        pg8::gemm_phase<pg8::EpiProj, pg8::StaticOrder, true, true, true>(F.lds + RING_OFF, g, S, E);
        if (BOTH(2)) GRID_BAR(2);
    }
    if (IN(3)) { p3_rows(F); if (BOTH(3)) GRID_BAR(3); }
    if (IN(4)) {
        const idx_body::IdxTensors IT{F.IDX, F.IW, F.MASKB};
        idx_body::idx_phase(F.lds + RING_OFF, IT, F.vcu, F.G);
        if (BOTH(4)) GRID_BAR(4);
    }
    if (IN(5)) {
        const attn_body::AttnTensors AT{(const attn_body::bf16*)F.ATT, (const attn_body::bf16*)(F.ATT + 512), (const attn_body::bf16*)(F.ATT + 1024), F.MASKB, (const attn_body::bf16*)(F.ATT + 1536), F.gn_attn, F.YCAT};
        const attn_body::StaticOrder S((int)F.G, (int)blockIdx.x);
        attn_body::attn_phase<attn_body::StaticOrder>((char*)lds + RING_OFF, AT, S);
        if (BOTH(5)) GRID_BAR(5);
    }
    if (IN(6)) {
        pg8::Gemm g{F.YCAT, F.WOUT, M, D, D}; pg8::StaticOrder S; S.init(M, D, F.G, (int)blockIdx.x);
        pg8::EpiOut E{F.x, F.out, D, F.MOD + 2 * D, 3 * D, T};
        pg8::gemm_phase<pg8::EpiOut, pg8::StaticOrder, false, true, true>(F.lds + RING_OFF, g, S, E);
        if (BOTH(6)) GRID_BAR(6);
    }
    if (IN(7)) { p7_rows(F); }
#undef IN
#undef BOTH
}

extern "C" void kernel_launch(void* const* d_in, const int* in_sizes, int n_in, void* d_out, int out_size, void* d_ws, size_t ws_size, hipStream_t stream) {
    static int grid = 0;
    if (grid == 0) {
        if (n_in != 13 || in_sizes[0] != M * D || out_size != M * D || ws_size < WS_END) { fprintf(stderr, "kernel_launch: unexpected shapes (n_in %d, in0 %d, out %d, ws %zu); nothing launched\n", n_in, n_in > 0 ? in_sizes[0] : -1, out_size, ws_size); grid = -1; return; }
        int dev = 0, cus = 0, per_cu = 0;
        if (hipGetDevice(&dev) != hipSuccess || hipDeviceGetAttribute(&cus, hipDeviceAttributeMultiprocessorCount, dev) != hipSuccess) { grid = -1; return; }
        if (hipFuncSetAttribute((const void*)fwd_kernel, hipFuncAttributeMaxDynamicSharedMemorySize, LDS_BYTES) != hipSuccess) { fprintf(stderr, "kernel_launch: hipFuncSetAttribute failed\n"); grid = -1; return; }
        if (hipOccupancyMaxActiveBlocksPerMultiprocessor(&per_cu, (const void*)fwd_kernel, NWAVES * 64, LDS_BYTES) != hipSuccess || per_cu < 1)
            fprintf(stderr, "kernel_launch: note: occupancy query reports %d workgroups per CU\n", per_cu);
        (void)hipGetLastError();
        grid = cus;
    }
    if (grid < 0) return;
    if (hipMemsetAsync((char*)d_ws + WS_CTL, 0, CTL_ZERO_BYTES, stream) != hipSuccess) return;
    Args a{};
    for (int i = 0; i < 13; ++i) a.in[i] = d_in[i];
    a.out = (float*)d_out; a.ws = (unsigned char*)d_ws;
    { float f[8]; for (int i = 0; i < 8; ++i) f[i] = (float)pow(500000.0, -(double)i / 8.0); a.if0 = f[0]; a.if1 = f[1]; a.if2 = f[2]; a.if3 = f[3]; a.if4 = f[4]; a.if5 = f[5]; a.if6 = f[6]; a.if7 = f[7]; }
    for (int li = 0; li < N_LAUNCHES; ++li) {
        a.ph_lo = (N_LAUNCHES == PER_PHASE) ? li : 0; a.ph_hi = (N_LAUNCHES == PER_PHASE) ? li + 1 : PER_PHASE;
        hipLaunchKernelGGL(fwd_kernel, dim3(grid), dim3(NWAVES * 64), LDS_BYTES, stream, a);
        const hipError_t le = hipPeekAtLastError();
        if (le != hipSuccess) { fprintf(stderr, "kernel_launch: launch %d failed: %s\n", li, hipGetErrorName(le)); break; }
    }
}
```
